# Optimizing an MI355X kernel written in HIP

```python
import jax, jax.numpy as jnp
from jax import lax
import numpy as np

D_MODEL = 1024
BATCH = 16
SEQ = 2048
DEPTH = 4

CHUNK = 64
N_MIXERS = 2
N_CONV_LAYERS = (DEPTH + 1) // 2
N_SSD_LAYERS = DEPTH // 2
N_MOD = 6
EPS = 1e-6

SC_WIDTH = 3

M_EXPAND = 2
M_D_INNER = M_EXPAND * D_MODEL
M_HEAD_DIM = 64
M_N_HEADS = M_D_INNER // M_HEAD_DIM
M_N_GROUPS = 8
M_HEADS_PER_GROUP = M_N_HEADS // M_N_GROUPS
M_D_STATE = 128
M_CONV_WIDTH = 4
M_CONV_DIM = M_D_INNER + 2 * M_N_GROUPS * M_D_STATE
M_IN_DIM = M_D_INNER + M_CONV_DIM + M_N_HEADS
SSD_CHUNK = CHUNK

D_FF = -(-8 * D_MODEL // (3 * 256)) * 256

kernel_name = "hybrid_shortconv_ssd_streaming_trunk"


def rms_normalize(x):
    xf = x.astype(jnp.float32)
    xf = xf * lax.rsqrt(jnp.mean(xf * xf, axis=-1, keepdims=True) + EPS)
    return xf.astype(x.dtype)


def rmsnorm(x, g):
    return rms_normalize(x) * g


def causal_depthwise_conv(x, w):
    k_width = w.shape[0]
    s = x.shape[1]
    xp = jnp.pad(x, ((0, 0), (k_width - 1, 0), (0, 0)))
    y = w[0] * xp[:, 0:s]
    for k in range(1, k_width):
        y = y + w[k] * xp[:, k:k + s]
    return y


def short_conv_mixer(h, w_in, conv_w, w_out):
    b_gate, c_gate, v = jnp.split(h @ w_in, 3, axis=-1)
    u = causal_depthwise_conv(c_gate * v, conv_w)
    return (b_gate * u) @ w_out


def ssd_chunked(xh, dt, a, bm, cm):
    bsz, s, g, r, p = xh.shape
    n = bm.shape[-1]
    nc, l = s // SSD_CHUNK, SSD_CHUNK
    dtype = xh.dtype
    xdt = (xh * dt[..., None].astype(dtype)).reshape(bsz, nc, l, g, r, p)
    bm = bm.reshape(bsz, nc, l, g, n)
    cm = cm.reshape(bsz, nc, l, g, n)
    cs = jnp.cumsum((dt * a).reshape(bsz, nc, l, g, r), axis=2)
    causal = jnp.tril(jnp.ones((l, l), dtype=bool))[None, None, :, :, None, None]
    seg = cs[:, :, :, None] - cs[:, :, None]
    decay = jnp.exp(jnp.where(causal, seg, -jnp.inf)).astype(dtype)
    cb = jnp.einsum('bclgn,bcsgn->bclsg', cm, bm)
    y_diag = jnp.einsum('bclsgr,bcsgrp->bclgrp', cb[..., None] * decay, xdt)
    decay_to_end = jnp.exp(cs[:, :, -1:] - cs).astype(dtype)
    states = jnp.einsum('bclgn,bclgr,bclgrp->bcgrpn', bm, decay_to_end, xdt)
    chunk_decay = jnp.exp(cs[:, :, -1]).astype(dtype)

    def step(state, inp):
        st, dec = inp
        return state * dec[..., None, None] + st, state

    h0 = jnp.zeros((bsz, g, r, p, n), dtype)
    _, prev = lax.scan(step, h0, (jnp.moveaxis(states, 1, 0), jnp.moveaxis(chunk_decay, 1, 0)))
    prev = jnp.moveaxis(prev, 0, 1)
    y_off = jnp.einsum('bclgn,bcgrpn,bclgr->bclgrp', cm, prev, jnp.exp(cs).astype(dtype))
    return (y_diag + y_off).reshape(bsz, s, g, r, p)


def ssd_mixer(h, w_in, conv_w, conv_b, dt_bias, a_log, d_skip, norm_g, w_out):
    bsz, s, _ = h.shape
    g, r, p, n = M_N_GROUPS, M_HEADS_PER_GROUP, M_HEAD_DIM, M_D_STATE
    z, xbc, dt_raw = jnp.split(h @ w_in, [M_D_INNER, M_D_INNER + M_CONV_DIM], axis=-1)
    xbc = jax.nn.silu(causal_depthwise_conv(xbc, conv_w) + conv_b)
    xs, bm, cm = jnp.split(xbc, [M_D_INNER, M_D_INNER + g * n], axis=-1)
    xs = xs.reshape(bsz, s, g, r, p)
    bm = bm.reshape(bsz, s, g, n)
    cm = cm.reshape(bsz, s, g, n)
    dt = jax.nn.softplus(dt_raw.astype(jnp.float32) + dt_bias.astype(jnp.float32)).reshape(bsz, s, g, r)
    a = -jnp.exp(a_log.astype(jnp.float32)).reshape(g, r)
    y = ssd_chunked(xs, dt, a, bm, cm) + d_skip.reshape(g, r)[:, :, None] * xs
    y = y.reshape(bsz, s, M_D_INNER) * jax.nn.silu(z)
    y = rms_normalize(y.reshape(bsz, s, g, M_D_INNER // g)).reshape(bsz, s, M_D_INNER) * norm_g
    return y @ w_out


def swiglu_ffn(h, w_in, w_out):
    gate, up = jnp.split(h @ w_in, 2, axis=-1)
    return (jax.nn.silu(gate) * up) @ w_out


def setup_inputs(seed: int = 0) -> dict:
    key = jax.random.key(seed)
    ks = jax.random.split(key, 20)
    f32 = jnp.float32
    nrm = lambda k, shape, scale: jax.random.normal(k, shape, f32) * scale
    dt_init = jnp.exp(jax.random.uniform(ks[11], (N_SSD_LAYERS, M_N_HEADS), f32,
                                         np.log(1e-3), np.log(1e-1)))
    return {
        "x": nrm(ks[0], (BATCH, SEQ, D_MODEL), 1.0),
        "c": nrm(ks[1], (BATCH, D_MODEL), 1.0),
        "ada_w": nrm(ks[2], (D_MODEL, DEPTH * N_MOD * D_MODEL), 0.5 * D_MODEL ** -0.5),
        "ada_b": nrm(ks[3], (DEPTH * N_MOD * D_MODEL,), 0.02),
        "norm_g": 1.0 + nrm(ks[4], (DEPTH, 4, D_MODEL), 0.02),
        "a_w_in": nrm(ks[5], (N_CONV_LAYERS, D_MODEL, 3 * D_MODEL), D_MODEL ** -0.5),
        "a_conv_w": nrm(ks[6], (N_CONV_LAYERS, SC_WIDTH, D_MODEL), SC_WIDTH ** -0.5),
        "a_w_out": nrm(ks[7], (N_CONV_LAYERS, D_MODEL, D_MODEL), D_MODEL ** -0.5),
        "m_w_in": nrm(ks[8], (N_SSD_LAYERS, D_MODEL, M_IN_DIM), D_MODEL ** -0.5),
        "m_conv_w": nrm(ks[9], (N_SSD_LAYERS, M_CONV_WIDTH, M_CONV_DIM), M_CONV_WIDTH ** -0.5),
        "m_conv_b": nrm(ks[10], (N_SSD_LAYERS, M_CONV_DIM), 0.02),
        "m_dt_bias": dt_init + jnp.log(-jnp.expm1(-dt_init)),
        "m_a_log": jnp.log(jax.random.uniform(ks[12], (N_SSD_LAYERS, M_N_HEADS), f32, 1.0, 16.0)),
        "m_d": 1.0 + nrm(ks[13], (N_SSD_LAYERS, M_N_HEADS), 0.1),
        "m_norm_g": 1.0 + nrm(ks[14], (N_SSD_LAYERS, M_D_INNER), 0.02),
        "m_w_out": nrm(ks[15], (N_SSD_LAYERS, M_D_INNER, D_MODEL), M_D_INNER ** -0.5),
        "f_w_in": nrm(ks[16], (DEPTH, D_MODEL, 2 * D_FF), D_MODEL ** -0.5),
        "f_w_out": nrm(ks[17], (DEPTH, D_FF, D_MODEL), D_FF ** -0.5),
    }


def reference(x, c, ada_w, ada_b, norm_g, a_w_in, a_conv_w, a_w_out, m_w_in, m_conv_w,
              m_conv_b, m_dt_bias, m_a_log, m_d, m_norm_g, m_w_out, f_w_in, f_w_out):
    bsz = x.shape[0]
    mod = (jax.nn.silu(c) @ ada_w + ada_b).reshape(bsz, DEPTH, 2, 3, D_MODEL)
    for i in range(DEPTH):
        j = i // N_MIXERS
        shift, scale, gate = (mod[:, i, 0, k][:, None, :] for k in range(3))
        h = rmsnorm(x, norm_g[i, 0]) * (1.0 + scale) + shift
        if i % N_MIXERS == 0:
            y = short_conv_mixer(h, a_w_in[j], a_conv_w[j], a_w_out[j])
        else:
            y = ssd_mixer(h, m_w_in[j], m_conv_w[j], m_conv_b[j], m_dt_bias[j], m_a_log[j],
                          m_d[j], m_norm_g[j], m_w_out[j])
        x = x + gate * rmsnorm(y, norm_g[i, 1])
        shift, scale, gate = (mod[:, i, 1, k][:, None, :] for k in range(3))
        h = rmsnorm(x, norm_g[i, 2]) * (1.0 + scale) + shift
        y = swiglu_ffn(h, f_w_in[i], f_w_out[i])
        x = x + gate * rmsnorm(y, norm_g[i, 3])
    return x
```

```cpp
#include <hip/hip_runtime.h>
#include <hip/hip_cooperative_groups.h>
#include <cstdio>
namespace cg = cooperative_groups;

#ifndef COOP
#define COOP 1
#endif

typedef unsigned char uchar;
typedef unsigned short bf16_t;
typedef short bf16x8 __attribute__((ext_vector_type(8)));
typedef float f32x4 __attribute__((ext_vector_type(4)));
typedef float f32x2 __attribute__((ext_vector_type(2)));
typedef unsigned u32x4 __attribute__((ext_vector_type(4)));
typedef unsigned u32x2 __attribute__((ext_vector_type(2)));
#define LAS __attribute__((address_space(3)))

constexpr int D = 1024, NB = 16, SEQ = 2048, M = NB * SEQ, DFF = 2816, DI = 2048, NHEAD = 32;
constexpr int CONVD = 4096, MIN_N = 6176, MIN_NP = 6400, ZXC = 6144, NMODV = 24576;
constexpr int LDH = 1088, LDZ = 6208, LDW1 = 1088, LDW2 = 2112;
constexpr int MH = M / 2;
constexpr float EPS = 1e-6f;
constexpr int LDS_MAIN = 131072;
constexpr int LDS_RT = LDS_MAIN + 256;
constexpr int LDS_MM = LDS_RT;
constexpr int LDS_WL = LDS_RT + 2 * 64 * 144;
constexpr int LDS_BYTES = LDS_WL + 3 * 5 * 128 * 4;

constexpr size_t WS_BAR   = 0;
constexpr size_t WS_MOD   = 16384;
constexpr size_t SZ_AWIN  = (size_t)3072 * 1024 * 2;
constexpr size_t SZ_AWOUT = (size_t)1024 * 1024 * 2;
constexpr size_t SZ_MWIN  = (size_t)MIN_NP * 1024 * 2;
constexpr size_t SZ_MWOUT = (size_t)1024 * 2048 * 2;
constexpr size_t SZ_FWIN  = (size_t)5632 * 1024 * 2;
constexpr size_t SZ_FWOUT = (size_t)1024 * 2816 * 2;
constexpr size_t OFF_W2   = (size_t)MIN_NP * LDW1 * 2;
constexpr size_t SZ_WMIX  = OFF_W2 + (size_t)1024 * LDW2 * 2;
constexpr size_t OFF_F2   = (size_t)5632 * LDW1 * 2;
constexpr size_t SZ_WFFN  = OFF_F2 + (size_t)1024 * 2816 * 2;
constexpr size_t WS_WMIX  = WS_MOD + (size_t)NB * NMODV * 4;
constexpr size_t WS_WFFN  = WS_WMIX + SZ_WMIX;
constexpr size_t WS_XB    = WS_WFFN + SZ_WFFN;
constexpr size_t WS_S     = WS_XB + (size_t)M * 1024 * 2;
constexpr size_t WS_BCV   = WS_S;
constexpr size_t WS_T     = WS_BCV + (size_t)M * 3072 * 2;
constexpr size_t WS_ZX    = WS_S;
constexpr size_t WS_DTR   = WS_ZX + (size_t)M * LDZ * 2;
constexpr size_t WS_SSQ   = WS_DTR + (size_t)M * 32 * 4;
constexpr size_t WS_SSD_END = WS_SSQ + (size_t)M * 16 * 4;
constexpr size_t WS_ACT   = WS_S;
constexpr size_t WS_YL    = WS_S + (size_t)M * 3072 * 2;
constexpr size_t WS_END   = WS_SSD_END;
static_assert(WS_T + (size_t)M * LDH * 2 <= WS_END && WS_YL + (size_t)M * LDH * 2 <= WS_END && WS_END <= ((size_t)512 << 20), "workspace map");

struct Params {
    const float *x, *c, *ada_w, *ada_b, *norm_g, *a_w_in, *a_conv_w, *a_w_out, *m_w_in, *m_conv_w, *m_conv_b, *m_dt_bias, *m_a_log, *m_d, *m_norm_g, *m_w_out, *f_w_in, *f_w_out;
    float* out; uchar* ws; int ph_lo, ph_hi;
};

__device__ __forceinline__ unsigned pk2(float lo, float hi) { unsigned r; asm("v_cvt_pk_bf16_f32 %0, %1, %2" : "=v"(r) : "v"(lo), "v"(hi)); return r; }
__device__ __forceinline__ float bflo(unsigned u) { return __uint_as_float(u << 16); }
__device__ __forceinline__ float bfhi(unsigned u) { return __uint_as_float(u & 0xffff0000u); }
__device__ __forceinline__ void unpack8(const u32x4 v, float (&o)[8]) {
    o[0] = bflo(v.x); o[1] = bfhi(v.x); o[2] = bflo(v.y); o[3] = bfhi(v.y); o[4] = bflo(v.z); o[5] = bfhi(v.z); o[6] = bflo(v.w); o[7] = bfhi(v.w);
}
__device__ __forceinline__ u32x4 pack8(const float (&o)[8]) { u32x4 r; r.x = pk2(o[0], o[1]); r.y = pk2(o[2], o[3]); r.z = pk2(o[4], o[5]); r.w = pk2(o[6], o[7]); return r; }
__device__ __forceinline__ float wave_sum(float v) {
#pragma unroll
    for (int o = 1; o < 64; o <<= 1) v += __shfl_xor(v, o);
    return v;
}
__device__ __forceinline__ int opaque_tid() { int t = threadIdx.x; asm volatile("" : "+v"(t)); return t; }
__device__ __forceinline__ int opaque_bid() { int b = blockIdx.x; asm volatile("" : "+s"(b)); return b; }
__device__ __forceinline__ float silu_f(float v) { return v * __builtin_amdgcn_rcpf(1.f + __expf(-v)); }


#define XB_TMO      128
#define XB_XCNT(j)  (256  + 64 * (j))
#define XB_XSUB(j)  (1280 + 64 * (j))
#define XB_XGEN(j)  (2304 + 64 * (j))
#define XB_TOP      3328
#define XB_TOPGEN   3392
#define XCD_BAR_WORDS 3456
#define XB_SPIN_CAP (1u << 22)
__device__ __forceinline__ unsigned xb_ld(unsigned* p)              { return __hip_atomic_load(p, __ATOMIC_RELAXED, __HIP_MEMORY_SCOPE_AGENT); }
__device__ __forceinline__ unsigned xb_add(unsigned* p, unsigned v) { return __hip_atomic_fetch_add(p, v, __ATOMIC_RELAXED, __HIP_MEMORY_SCOPE_AGENT); }
__device__ __forceinline__ unsigned xb_xcc_id() { return (unsigned)__builtin_amdgcn_s_getreg((3 << 11) | 20) & 0xFu; }
#define XB_SPIN(cond, bar) do { unsigned _sp = 0; while (cond) { __builtin_amdgcn_s_sleep(1); \
    if ((++_sp & 255u) == 0u) { if (xb_ld(&(bar)[XB_TMO])) break; if (_sp > XB_SPIN_CAP) { atomicAdd(&(bar)[XB_TMO], 1u); break; } } } } while (0)
struct XcdBarrier { unsigned* bar; unsigned x; volatile LAS unsigned* st; };
__device__ __forceinline__ XcdBarrier xcd_barrier_post(unsigned* bar, volatile LAS unsigned* st) {
    XcdBarrier b; b.bar = bar; b.x = xb_xcc_id(); b.st = st;
    if (threadIdx.x == 0) (void)xb_add(&bar[XB_XCNT(b.x)], 1u);
    return b;
}
__device__ __forceinline__ void xcd_barrier_complete(unsigned* bar, unsigned x, unsigned& nloc, unsigned& nx) {
    const unsigned G = gridDim.x * gridDim.y * gridDim.z;
    unsigned sum, cnt, mine, sp = 0u;
    for (;;) {
        sum = 0u; cnt = 0u; mine = 0u;
#pragma unroll
        for (unsigned j = 0; j < 16; ++j) { const unsigned c = xb_ld(&bar[XB_XCNT(j)]); sum += c; cnt += (c > 0u) ? 1u : 0u; mine = (j == x) ? c : mine; }
        if (sum == G) break;
        __builtin_amdgcn_s_sleep(1);
        if ((++sp & 255u) == 0u) { if (xb_ld(&bar[XB_TMO])) break; if (sp > XB_SPIN_CAP) { atomicAdd(&bar[XB_TMO], 1u); break; } }
    }
    nloc = mine > 0u ? mine : 1u; nx = cnt > 0u ? cnt : 1u;
}
__device__ __forceinline__ void xcd_barrier(const XcdBarrier& b) {
    asm volatile("s_waitcnt vmcnt(0)" ::: "memory");
    __syncthreads();
    if (threadIdx.x == 0) {
        unsigned* bar = b.bar;
        __builtin_amdgcn_s_waitcnt(0);
        unsigned nloc = b.st[0], nx = b.st[1];
        if (nloc == 0u) { xcd_barrier_complete(bar, b.x, nloc, nx); b.st[0] = nloc; b.st[1] = nx; }
        const unsigned old = xb_add(&bar[XB_XSUB(b.x)], 1u);
        const unsigned gen = old / nloc;
        if (old + 1u == (gen + 1u) * nloc) {
            __builtin_amdgcn_fence(__ATOMIC_RELEASE, "agent");
            asm volatile("s_waitcnt vmcnt(0)" ::: "memory");
            const unsigned og = xb_add(&bar[XB_TOP], 1u);
            const unsigned tg = og / nx;
            if (og + 1u == (tg + 1u) * nx) xb_add(&bar[XB_TOPGEN], 1u);
            else XB_SPIN(xb_ld(&bar[XB_TOPGEN]) == tg, bar);
            __builtin_amdgcn_fence(__ATOMIC_ACQUIRE, "agent");
            xb_add(&bar[XB_XGEN(b.x)], 1u);
            asm volatile("s_waitcnt vmcnt(0)" ::: "memory");
        } else {
            XB_SPIN(xb_ld(&bar[XB_XGEN(b.x)]) == gen, bar);
            __builtin_amdgcn_fence(__ATOMIC_ACQUIRE, "agent");
            asm volatile("s_waitcnt vmcnt(0)" ::: "memory");
        }
    }
    __syncthreads();
}

namespace pg8 {
constexpr int BM = 256, BK = 64, HALF = 128, HTB = HALF * BK * 2, STAGE_BYTES = 8 * HTB, NXCD = 8, WGM = 8;
__device__ __forceinline__ int lds_byte(int r, int c) { const int st = (r >> 4) * 2 + (c >> 5), rr = r & 15, cc = c & 31, ob = rr * 64 + cc * 2; return st * 1024 + (ob ^ (((ob >> 9) & 1) << 5)); }
__device__ __forceinline__ void stage_rc(int b, int& R, int& C) { const int st = b / 1024, sb = b % 1024, swz = sb ^ (((sb >> 9) & 1) << 5); R = (st >> 1) * 16 + swz / 64; C = (st & 1) * 32 + (swz % 64) / 2; }
__device__ __forceinline__ int perm32(int rho) { const int n = rho >> 4, i = rho & 15; return 8 * (i >> 2) + 4 * n + (i & 3); }
struct Unit { int pm, pn; };
struct Gemm { const bf16_t* A; const bf16_t* Bt; int M, N, K, lda, ldb; const float* ssq; };
struct StaticOrder {
    int nM, nN, nwg, G, c;
    __device__ void init(int M_, int N_, int G_, int c_) { nM = M_ / BM; nN = N_ / BM; nwg = nM * nN; G = G_; c = c_; }
    __device__ bool next(int i, Unit& u) const {
        const long L = (long)i * G + c; if (L >= nwg) return false;
        int wgid = (int)L; { const int q = nwg / NXCD, r = nwg % NXCD, xcd = wgid % NXCD, off = wgid / NXCD; wgid = (xcd < r ? xcd * (q + 1) : r * (q + 1) + (xcd - r) * q) + off; }
        const int nig = WGM * nN, gid = wgid / nig, fm = gid * WGM, gsz = (nM - fm) < WGM ? (nM - fm) : WGM;
        u.pm = fm + ((wgid % nig) % gsz); u.pn = (wgid % nig) / gsz; return true;
    }
};

#ifndef PG8_SP2
#define PG8_SP2 true
#endif
#ifndef PG8_ALIGN
#define PG8_ALIGN true
#endif
template <class Epi, bool ALIGN_EPI = PG8_ALIGN, bool SP2 = PG8_SP2>
__device__ __forceinline__ void gemm_phase(LAS uchar* lds, const Gemm g, const StaticOrder& S, const Epi& E) {
    const int tid = opaque_tid(), wid = __builtin_amdgcn_readfirstlane(tid >> 6), lane = tid & 63, wr = wid >> 2, wc = wid & 3, fr = lane & 15, fq = lane >> 4;
    const int K = g.K, nt = K / BK;
    unsigned voffA[2], voffB[2];
#pragma unroll
    for (int i = 0; i < 2; ++i) { int R, C; stage_rc(tid * 16 + i * 8192, R, C); const int Rb = (R & ~31) + perm32(R & 31);
        voffA[i] = (unsigned)(R * g.lda + C) * 2u; voffB[i] = (unsigned)(Rb * g.ldb + C) * 2u; }
    const size_t kstep = (size_t)(BK * 2);
    const size_t hstepB = (size_t)HALF * g.ldb * 2, hstepA = (size_t)HALF * g.lda * 2;
    const size_t tstepB = 2 * hstepB, tstepA = 2 * hstepA;
    const unsigned ldsw = (unsigned)wid * 1024u;
    const int aoff = lds_byte(wr * 64 + fr, fq * 8), boff = lds_byte(wc * 32 + fr, fq * 8);
#define PG8_SA(b, h) (((b) * 2 + (h)) * HTB)
#define PG8_SB(b, h) ((4 + (b) * 2 + (h)) * HTB)
#define PG8_STAGE(bufoff, gbase, voff) do { _Pragma("unroll") for (int _i = 0; _i < 2; ++_i) \
        __builtin_amdgcn_global_load_lds((const unsigned*)((const char*)(gbase) + (voff)[_i]), (LAS unsigned*)(lds + (bufoff) + ldsw + _i * 8192), 16, 0, 0); } while (0)
#define PG8_LDA(dst, b, h) do { _Pragma("unroll") for (int m = 0; m < 4; ++m) _Pragma("unroll") for (int k = 0; k < 2; ++k) dst[m][k] = *(const LAS bf16x8*)(lds + PG8_SA(b, h) + aoff + m * 2048 + k * 1024); } while (0)
#define PG8_LDB(dst, b, h) do { _Pragma("unroll") for (int n = 0; n < 2; ++n) _Pragma("unroll") for (int k = 0; k < 2; ++k) dst[n][k] = *(const LAS bf16x8*)(lds + PG8_SB(b, h) + boff + n * 2048 + k * 1024); } while (0)
#define PG8_MMA(ai, bj, At, Bt) do { __builtin_amdgcn_s_setprio(1); _Pragma("unroll") for (int m = 0; m < 4; ++m) _Pragma("unroll") for (int n = 0; n < 2; ++n) _Pragma("unroll") for (int k = 0; k < 2; ++k) \
        acc[ai][bj][m][n] = __builtin_amdgcn_mfma_f32_16x16x32_bf16(Bt[n][k], At[m][k], acc[ai][bj][m][n], 0, 0, 0); __builtin_amdgcn_s_setprio(0); } while (0)
#define PG8_WAIT_V(n) asm volatile("s_waitcnt vmcnt(" #n ")" ::: "memory")
#define PG8_WAIT_L(n) asm volatile("s_waitcnt lgkmcnt(" #n ")" ::: "memory")
#define PG8_BAR __builtin_amdgcn_s_barrier()
#define PG8_SCHED __builtin_amdgcn_sched_barrier(0)
    Unit cur, nxt; int ui = 0;
    if constexpr (Epi::GROUPS) {
        LAS float* rt = (LAS float*)(lds + LDS_RT);
#pragma unroll 1
        for (int u = 0; u < 2; ++u) { Unit uu; if (!S.next(u, uu)) break;
            if (tid < 256) { const float* sp = g.ssq + (size_t)(uu.pm * 256 + tid) * 16; float r[8];
#pragma unroll
                for (int q = 0; q < 8; ++q) r[q] = rsqrtf((sp[2 * q] + sp[2 * q + 1]) * (1.f / 256.f) + EPS);
#pragma unroll
                for (int q = 0; q < 8; ++q) rt[(u * 256 + tid) * 8 + q] = (q < 7) ? r[q] * __builtin_amdgcn_rcpf(r[q + 1]) : r[7]; } }
        __syncthreads();
    }
    if (!S.next(0, cur)) return;
    f32x4 acc[2][2][4][2];
#pragma unroll
    for (int a = 0; a < 2; ++a)
#pragma unroll
        for (int b = 0; b < 2; ++b)
#pragma unroll
            for (int m = 0; m < 4; ++m)
#pragma unroll
                for (int n = 0; n < 2; ++n) acc[a][b][m][n] = (f32x4){0.f, 0.f, 0.f, 0.f};
    bf16x8 At[4][2], B0[2][2], B1[2][2];
    const char* cA = (const char*)g.A + (size_t)cur.pm * tstepA; const char* cB = (const char*)g.Bt + (size_t)cur.pn * tstepB;
    if constexpr (SP2) {
        PG8_STAGE(PG8_SB(0, 0), cB, voffB); PG8_STAGE(PG8_SB(0, 1), cB + hstepB, voffB); PG8_STAGE(PG8_SA(0, 0), cA, voffA); PG8_STAGE(PG8_SA(0, 1), cA + hstepA, voffA);
        if (wr == 1) PG8_BAR;
        PG8_WAIT_V(2); PG8_BAR;
        PG8_STAGE(PG8_SB(1, 0), cB + kstep, voffB); PG8_STAGE(PG8_SA(1, 0), cA + kstep, voffA); PG8_STAGE(PG8_SB(1, 1), cB + hstepB + kstep, voffB);
        PG8_WAIT_V(6); PG8_BAR;
    } else {
    PG8_STAGE(PG8_SB(0, 0), cB, voffB); PG8_STAGE(PG8_SA(0, 0), cA, voffA); PG8_STAGE(PG8_SB(0, 1), cB + hstepB, voffB); PG8_STAGE(PG8_SA(0, 1), cA + hstepA, voffA);
    if (wr == 1) PG8_BAR;
    PG8_WAIT_V(4); PG8_BAR;
    PG8_STAGE(PG8_SB(1, 0), cB + kstep, voffB); PG8_STAGE(PG8_SA(1, 0), cA + kstep, voffA); PG8_STAGE(PG8_SB(1, 1), cB + hstepB + kstep, voffB);
    PG8_WAIT_V(6); PG8_BAR;
    }
    for (;;) {
        const bool has_next = S.next(ui + 1, nxt);
        const char* nA = has_next ? (const char*)g.A + (size_t)nxt.pm * tstepA : cA; const char* nB = has_next ? (const char*)g.Bt + (size_t)nxt.pn * tstepB : cB;
        const int tblk = Epi::GROUPS ? 4 : nt;
#pragma unroll 1
        for (int tb = 0; tb < nt; tb += tblk) {
        if constexpr (Epi::GROUPS) { if (tb > 0) {
            const LAS float* rt = (const LAS float*)(lds + LDS_RT) + ((ui & 1) * 256 + wr * 64 + fr) * 8 + ((tb >> 2) - 1);
#pragma unroll
            for (int a = 0; a < 2; ++a)
#pragma unroll
                for (int m = 0; m < 4; ++m) { const float f = rt[(a * 128 + m * 16) * 8];
#pragma unroll
                    for (int b = 0; b < 2; ++b)
#pragma unroll
                        for (int n = 0; n < 2; ++n) acc[a][b][m][n] *= f; } } }
#pragma unroll 1
        for (int t = tb; t < tb + tblk; t += 2) {
            const bool last = (t == nt - 2);
            const char* a1 = cA + (size_t)(t + 1) * kstep;
            const char* a2 = last ? nA : cA + (size_t)(t + 2) * kstep; const char* b2 = last ? nB : cB + (size_t)(t + 2) * kstep;
            const char* a3 = a2 + kstep; const char* b3 = b2 + kstep;
            if constexpr (SP2) {
            PG8_LDB(B0, 0, 0); PG8_LDB(B1, 0, 1); PG8_SCHED; PG8_LDA(At, 0, 0); PG8_STAGE(PG8_SA(1, 1), a1 + hstepA, voffA);
            PG8_WAIT_V(8); PG8_WAIT_L(0); PG8_BAR; PG8_MMA(0, 0, At, B0); PG8_MMA(0, 1, At, B1); PG8_BAR; PG8_SCHED;
            PG8_LDA(At, 0, 1); PG8_STAGE(PG8_SB(0, 0), b2, voffB); PG8_STAGE(PG8_SB(0, 1), b2 + hstepB, voffB); PG8_STAGE(PG8_SA(0, 0), a2, voffA);
            PG8_WAIT_V(8); PG8_WAIT_L(0); PG8_BAR; PG8_MMA(1, 0, At, B0); PG8_MMA(1, 1, At, B1); PG8_BAR; PG8_SCHED;
            PG8_LDB(B0, 1, 0); PG8_LDB(B1, 1, 1); PG8_SCHED; PG8_LDA(At, 1, 0); PG8_STAGE(PG8_SA(0, 1), a2 + hstepA, voffA);
            PG8_WAIT_V(8); PG8_WAIT_L(0); PG8_BAR; PG8_MMA(0, 0, At, B0); PG8_MMA(0, 1, At, B1); PG8_BAR; PG8_SCHED;
            PG8_LDA(At, 1, 1); PG8_STAGE(PG8_SB(1, 0), b3, voffB); PG8_STAGE(PG8_SB(1, 1), b3 + hstepB, voffB); PG8_STAGE(PG8_SA(1, 0), a3, voffA);
            PG8_WAIT_V(8); PG8_WAIT_L(0); PG8_BAR; PG8_MMA(1, 0, At, B0); PG8_MMA(1, 1, At, B1); PG8_BAR; PG8_SCHED;
            } else {
            PG8_LDB(B0, 0, 0); PG8_SCHED; PG8_LDA(At, 0, 0); PG8_STAGE(PG8_SA(1, 1), a1 + hstepA, voffA);
            PG8_WAIT_L(8); PG8_BAR; PG8_WAIT_L(0); PG8_MMA(0, 0, At, B0); PG8_BAR; PG8_SCHED;
            PG8_LDB(B1, 0, 1); PG8_STAGE(PG8_SB(0, 0), b2, voffB);
            PG8_BAR; PG8_WAIT_L(0); PG8_MMA(0, 1, At, B1); PG8_BAR;
            PG8_LDA(At, 0, 1); PG8_STAGE(PG8_SA(0, 0), a2, voffA);
            PG8_BAR; PG8_WAIT_L(0); PG8_MMA(1, 0, At, B0); PG8_BAR; PG8_SCHED;
            PG8_STAGE(PG8_SB(0, 1), b2 + hstepB, voffB);
            PG8_WAIT_V(6); PG8_BAR; PG8_MMA(1, 1, At, B1); PG8_BAR;
            PG8_LDB(B0, 1, 0); PG8_SCHED; PG8_LDA(At, 1, 0); PG8_STAGE(PG8_SA(0, 1), a2 + hstepA, voffA);
            PG8_WAIT_L(8); PG8_BAR; PG8_WAIT_L(0); PG8_MMA(0, 0, At, B0); PG8_BAR; PG8_SCHED;
            PG8_LDB(B1, 1, 1); PG8_STAGE(PG8_SB(1, 0), b3, voffB);
            PG8_BAR; PG8_WAIT_L(0); PG8_MMA(0, 1, At, B1); PG8_BAR;
            PG8_LDA(At, 1, 1); PG8_STAGE(PG8_SA(1, 0), a3, voffA);
            PG8_BAR; PG8_WAIT_L(0); PG8_MMA(1, 0, At, B0); PG8_BAR; PG8_SCHED;
            PG8_STAGE(PG8_SB(1, 1), b3 + hstepB, voffB);
            PG8_WAIT_V(6); PG8_BAR; PG8_MMA(1, 1, At, B1); PG8_BAR;
            }
        }
        }
        if constexpr (ALIGN_EPI) { if (wr == 0) PG8_BAR; }
        E(acc, cur, wr, wc, fr, fq, ui);
        if (!has_next) break;
#pragma unroll
        for (int a = 0; a < 2; ++a)
#pragma unroll
            for (int b = 0; b < 2; ++b)
#pragma unroll
                for (int m = 0; m < 4; ++m)
#pragma unroll
                    for (int n = 0; n < 2; ++n) acc[a][b][m][n] = (f32x4){0.f, 0.f, 0.f, 0.f};
        cur = nxt; cA = nA; cB = nB; ++ui;
        if constexpr (ALIGN_EPI) { if (wr == 1) PG8_BAR; }
    }
    PG8_WAIT_V(0);
    if constexpr (!ALIGN_EPI) { if (wr == 0) PG8_BAR; }
    PG8_BAR;
#undef PG8_SA
#undef PG8_SB
#undef PG8_STAGE
#undef PG8_LDA
#undef PG8_LDB
#undef PG8_MMA
#undef PG8_WAIT_V
#undef PG8_WAIT_L
#undef PG8_BAR
#undef PG8_SCHED
}
}

struct EpiStoreBf16 {
    static constexpr bool GROUPS = false;
    bf16_t* O; int ldc;
    __device__ __forceinline__ void operator()(const f32x4 (&acc)[2][2][4][2], const pg8::Unit& u, int wr, int wc, int fr, int fq, int) const {
        const int row0 = u.pm * 256 + wr * 64 + fr, col0 = u.pn * 256 + wc * 32 + 8 * fq;
#pragma unroll
        for (int ai = 0; ai < 2; ++ai)
#pragma unroll
            for (int m = 0; m < 4; ++m) { bf16_t* rowp = O + (size_t)(row0 + ai * 128 + m * 16) * ldc + col0;
#pragma unroll
                for (int bj = 0; bj < 2; ++bj) { const f32x4 v0 = acc[ai][bj][m][0], v1 = acc[ai][bj][m][1];
                    u32x4 o; o.x = pk2(v0[0], v0[1]); o.y = pk2(v0[2], v0[3]); o.z = pk2(v1[0], v1[1]); o.w = pk2(v1[2], v1[3]);
                    *(u32x4*)(rowp + bj * 128) = o; } }
    }
};
struct EpiStoreGroupNorm {
    static constexpr bool GROUPS = true;
    bf16_t* O; int ldc; const uchar* lds;
    __device__ __forceinline__ void operator()(const f32x4 (&acc)[2][2][4][2], const pg8::Unit& u, int wr, int wc, int fr, int fq, int ui) const {
        const int row0 = u.pm * 256 + wr * 64 + fr, col0 = u.pn * 256 + wc * 32 + 8 * fq;
        const float* rt = (const float*)(lds + LDS_RT) + ((ui & 1) * 256 + wr * 64 + fr) * 8 + 7;
#pragma unroll
        for (int ai = 0; ai < 2; ++ai)
#pragma unroll
            for (int m = 0; m < 4; ++m) { bf16_t* rowp = O + (size_t)(row0 + ai * 128 + m * 16) * ldc + col0; const float f = rt[(ai * 128 + m * 16) * 8];
#pragma unroll
                for (int bj = 0; bj < 2; ++bj) { const f32x4 v0 = acc[ai][bj][m][0] * f, v1 = acc[ai][bj][m][1] * f;
                    u32x4 o; o.x = pk2(v0[0], v0[1]); o.y = pk2(v0[2], v0[3]); o.z = pk2(v1[0], v1[1]); o.w = pk2(v1[2], v1[3]);
                    *(u32x4*)(rowp + bj * 128) = o; } }
    }
};
struct EpiBCV {
    static constexpr bool GROUPS = false;
    bf16_t* O;
    __device__ __forceinline__ void operator()(const f32x4 (&acc)[2][2][4][2], const pg8::Unit& u, int wr, int wc, int fr, int fq, int) const {
        const int row0 = u.pm * 256 + wr * 64 + fr;
        if (u.pn < 4) {
            const int col0 = u.pn * 256 + wc * 32 + 8 * fq;
#pragma unroll
            for (int ai = 0; ai < 2; ++ai)
#pragma unroll
                for (int m = 0; m < 4; ++m) { bf16_t* rowp = O + (size_t)(row0 + ai * 128 + m * 16) * 2048 + col0;
#pragma unroll
                    for (int bj = 0; bj < 2; ++bj) { const f32x4 v0 = acc[ai][bj][m][0], v1 = acc[ai][bj][m][1];
                        u32x4 o; o.x = pk2(v0[0], v0[1]); o.y = pk2(v0[2], v0[3]); o.z = pk2(v1[0], v1[1]); o.w = pk2(v1[2], v1[3]);
                        *(u32x4*)(rowp + bj * 128) = o; } }
        } else {
            const int col0 = 1024 + (u.pn - 4) * 128 + wc * 32 + 8 * fq;
#pragma unroll
            for (int ai = 0; ai < 2; ++ai)
#pragma unroll
                for (int m = 0; m < 4; ++m) { bf16_t* rowp = O + (size_t)(row0 + ai * 128 + m * 16) * 2048 + col0;
                    const f32x4 v0 = acc[ai][0][m][0] * acc[ai][1][m][0], v1 = acc[ai][0][m][1] * acc[ai][1][m][1];
                    u32x4 o; o.x = pk2(v0[0], v0[1]); o.y = pk2(v0[2], v0[3]); o.z = pk2(v1[0], v1[1]); o.w = pk2(v1[2], v1[3]);
                    *(u32x4*)rowp = o; }
        }
    }
};
struct EpiSwiGLU {
    static constexpr bool GROUPS = false;
    bf16_t* O;
    __device__ __forceinline__ void operator()(const f32x4 (&acc)[2][2][4][2], const pg8::Unit& u, int wr, int wc, int fr, int fq, int) const {
        const int row0 = u.pm * 256 + wr * 64 + fr, col0 = u.pn * 128 + wc * 32 + 8 * fq;
#pragma unroll
        for (int ai = 0; ai < 2; ++ai)
#pragma unroll
            for (int m = 0; m < 4; ++m) { bf16_t* rowp = O + (size_t)(row0 + ai * 128 + m * 16) * DFF + col0;
                float r[8];
#pragma unroll
                for (int n = 0; n < 2; ++n)
#pragma unroll
                    for (int i = 0; i < 4; ++i) { const float gt = acc[ai][0][m][n][i], up = acc[ai][1][m][n][i]; r[n * 4 + i] = silu_f(gt) * up; }
                *(u32x4*)rowp = pack8(r); }
    }
};
struct EpiSSDIn {
    static constexpr bool GROUPS = false;
    bf16_t* ZX; float* DT;
    __device__ __forceinline__ void operator()(const f32x4 (&acc)[2][2][4][2], const pg8::Unit& u, int wr, int wc, int fr, int fq, int) const {
        const int row0 = u.pm * 256 + wr * 64 + fr;
        if (u.pn < 24) {
            const int col0 = u.pn * 256 + wc * 32 + 8 * fq;
#pragma unroll
            for (int ai = 0; ai < 2; ++ai)
#pragma unroll
                for (int m = 0; m < 4; ++m) { bf16_t* rowp = ZX + (size_t)(row0 + ai * 128 + m * 16) * LDZ + col0;
#pragma unroll
                    for (int bj = 0; bj < 2; ++bj) { const f32x4 v0 = acc[ai][bj][m][0], v1 = acc[ai][bj][m][1];
                        u32x4 o; o.x = pk2(v0[0], v0[1]); o.y = pk2(v0[2], v0[3]); o.z = pk2(v1[0], v1[1]); o.w = pk2(v1[2], v1[3]);
                        *(u32x4*)(rowp + bj * 128) = o; } }
        } else if (wc == 0) {
#pragma unroll
            for (int ai = 0; ai < 2; ++ai)
#pragma unroll
                for (int m = 0; m < 4; ++m) { float* rowp = DT + (size_t)(row0 + ai * 128 + m * 16) * 32 + 8 * fq;
                    *(f32x4*)(rowp) = acc[ai][0][m][0]; *(f32x4*)(rowp + 4) = acc[ai][0][m][1]; }
        }
    }
};
template <class Epi> __device__ __forceinline__ void run_gemm(uchar* sm, const bf16_t* A, int lda, const bf16_t* Bt, int ldb, int Mr, int N, int K, const Epi& E, const float* ssq = nullptr) {
    pg8::StaticOrder S; S.init(Mr, N, (int)gridDim.x, opaque_bid());
    pg8::gemm_phase<Epi>((LAS uchar*)sm, pg8::Gemm{A, Bt, Mr, N, K, lda, ldb, ssq}, S, E);
}

__device__ __forceinline__ void convert_tile(const float* W, int K, int N, bf16_t* Wt, int ldw, int mode, int tile, float* scr, const float* kscale = nullptr) {
    const int tid = opaque_tid(), nkt = K / 64, nb = tile / nkt, kb = tile % nkt, n0 = nb * 64, k0 = kb * 64;
    { const int n4 = (tid & 15) * 4, kk0 = tid >> 4; const int np = n0 + n4;
      int col = np; if (mode == 1) col = ((np >> 7) & 1) * DFF + (np >> 8) * 128 + (np & 127);
      if (mode == 3 && np >= 1024) { const int q = np - 1024; col = 1024 + ((q >> 7) & 1) * 1024 + (q >> 8) * 128 + (q & 127); }
      const bool valid = col < N;
#pragma unroll
      for (int i = 0; i < 2; ++i) { const int kk = kk0 + 32 * i;
          f32x4 v = valid ? *(const f32x4*)(W + (size_t)(k0 + kk) * N + col) : (f32x4){0.f, 0.f, 0.f, 0.f};
          if (kscale) v *= kscale[k0 + kk];
          float* d = scr + kk * 65 + n4; d[0] = v[0]; d[1] = v[1]; d[2] = v[2]; d[3] = v[3]; } }
    __syncthreads();
    { const int nl = tid >> 3, kc = tid & 7; const float* sp = scr + (kc * 8) * 65 + nl;
      u32x4 o; o.x = pk2(sp[0], sp[65]); o.y = pk2(sp[2 * 65], sp[3 * 65]); o.z = pk2(sp[4 * 65], sp[5 * 65]); o.w = pk2(sp[6 * 65], sp[7 * 65]);
      *(u32x4*)(Wt + (size_t)(n0 + nl) * ldw + k0 + kc * 8) = o; }
    __syncthreads();
}
__device__ __forceinline__ void convert_layer_weights(const Params& p, uchar* sm, int i, bool mixer, bool ffn) {
    float* scr = (float*)sm;
    const int j = i >> 1, bid = opaque_bid();
    const int T_AWIN = (3072 / 64) * 16, T_AWOUT = 16 * 16, T_MWIN = (MIN_NP / 64) * 16, T_MWOUT = 16 * 32, T_FWIN = (5632 / 64) * 16, T_FWOUT = 16 * 44;
    const bool conv = (i & 1) == 0;
    const int t_in = conv ? T_AWIN : T_MWIN, t_out = conv ? T_AWOUT : T_MWOUT;
    const int n_mix = mixer ? t_in + t_out : 0, n_ffn = ffn ? T_FWIN + T_FWOUT : 0;
    for (int it = bid; it < n_mix + n_ffn; it += gridDim.x) {
        int r = it;
        if (r < n_mix) {
            if (conv) {
                if (r < t_in) convert_tile(p.a_w_in + (size_t)j * 1024 * 3072, 1024, 3072, (bf16_t*)(p.ws + WS_WMIX), LDW1, 3, r, scr);
                else convert_tile(p.a_w_out + (size_t)j * 1024 * 1024, 1024, 1024, (bf16_t*)(p.ws + WS_WMIX + OFF_W2), LDW1, 0, r - t_in, scr);
            } else {
                if (r < t_in) convert_tile(p.m_w_in + (size_t)j * 1024 * MIN_N, 1024, MIN_N, (bf16_t*)(p.ws + WS_WMIX), LDW1, 0, r, scr);
                else convert_tile(p.m_w_out + (size_t)j * 2048 * 1024, 2048, 1024, (bf16_t*)(p.ws + WS_WMIX + OFF_W2), LDW2, 0, r - t_in, scr, p.m_norm_g + (size_t)j * DI);
            }
            continue;
        }
        r -= n_mix;
        if (r < T_FWIN) convert_tile(p.f_w_in + (size_t)i * 1024 * 5632, 1024, 5632, (bf16_t*)(p.ws + WS_WFFN), LDW1, 1, r, scr);
        else convert_tile(p.f_w_out + (size_t)i * 2816 * 1024, 2816, 1024, (bf16_t*)(p.ws + WS_WFFN + OFF_F2), 2816, 0, r - T_FWIN, scr);
    }
}
__device__ __forceinline__ void phase_prologue(const Params& p, uchar* sm) {
    const int tid = opaque_tid(), w = tid >> 6, lane = tid & 63; const int bid = opaque_bid();
    float* mod = (float*)(p.ws + WS_MOD);
    float* sc = (float*)sm;
    float* red = sc + 16 * 1024;
    for (int i = tid; i < 16 * 1024; i += 512) sc[i] = silu_f(p.c[i]);
    __syncthreads();
    for (int item = bid; item < NMODV / 64; item += gridDim.x) {
        const int col = item * 64 + lane;
        float acc[16];
#pragma unroll
        for (int b = 0; b < 16; ++b) acc[b] = 0.f;
        const float* wp = p.ada_w + (size_t)(w * 128) * NMODV + col;
#pragma unroll 4
        for (int k = 0; k < 128; ++k) { const float wv = wp[(size_t)k * NMODV];
#pragma unroll
            for (int b = 0; b < 16; ++b) acc[b] += sc[b * 1024 + w * 128 + k] * wv; }
#pragma unroll
        for (int b = 0; b < 16; ++b) red[(w * 16 + b) * 64 + lane] = acc[b];
        __syncthreads();
        for (int o = tid; o < 1024; o += 512) { const int b = o >> 6, cl = o & 63; float s = p.ada_b[item * 64 + cl];
#pragma unroll
            for (int q = 0; q < 8; ++q) s += red[(q * 16 + b) * 64 + cl];
            mod[(size_t)b * NMODV + item * 64 + cl] = s; }
        __syncthreads();
    }
    convert_layer_weights(p, sm, 0, true, true);
}

__device__ __forceinline__ void phase_rowwise(const Params& p, const float* xs32, const bf16_t* xs16, float* xd32, bf16_t* xd16, const bf16_t* y, const float* gpost, int modres,
                                              bf16_t* hout, const float* gpre, int modh) {
    constexpr int RB = 4;
    const int tid = opaque_tid(), lane = tid & 63;
    const int gw = opaque_bid() * 8 + (tid >> 6), nw = gridDim.x * 8;
    const float* mod = (const float*)(p.ws + WS_MOD);
    for (int rg = gw; rg < M / RB; rg += nw) {
        const size_t row0 = (size_t)rg * RB;
        const float* modb = mod + (size_t)((rg * RB) >> 11) * NMODV;
        f32x4 xv[RB][4];
        if (xs32) {
#pragma unroll
            for (int r = 0; r < RB; ++r)
#pragma unroll
                for (int j = 0; j < 4; ++j) xv[r][j] = *(const f32x4*)(xs32 + (row0 + r) * D + lane * 4 + 256 * j);
        } else {
#pragma unroll
            for (int r = 0; r < RB; ++r)
#pragma unroll
                for (int j = 0; j < 4; ++j) { const u32x2 t = *(const u32x2*)(xs16 + (row0 + r) * D + lane * 4 + 256 * j);
                    xv[r][j][0] = bflo(t.x); xv[r][j][1] = bfhi(t.x); xv[r][j][2] = bflo(t.y); xv[r][j][3] = bfhi(t.y); }
        }
        if (y) {
            u32x2 yp[RB][4];
#pragma unroll
            for (int r = 0; r < RB; ++r)
#pragma unroll
                for (int j = 0; j < 4; ++j) yp[r][j] = *(const u32x2*)(y + (row0 + r) * LDH + lane * 4 + 256 * j);
            float ss[RB];
#pragma unroll
            for (int r = 0; r < RB; ++r) { ss[r] = 0.f;
#pragma unroll
                for (int j = 0; j < 4; ++j) { const float a = bflo(yp[r][j].x), b = bfhi(yp[r][j].x), c = bflo(yp[r][j].y), d = bfhi(yp[r][j].y); ss[r] += (a * a + b * b) + (c * c + d * d); } }
#pragma unroll
            for (int o = 1; o < 64; o <<= 1)
#pragma unroll
                for (int r = 0; r < RB; ++r) ss[r] += __shfl_xor(ss[r], o);
#pragma unroll
            for (int j = 0; j < 4; ++j) { const f32x4 gt = *(const f32x4*)(modb + modres + lane * 4 + 256 * j), gp = *(const f32x4*)(gpost + lane * 4 + 256 * j);
                const f32x4 gg = gt * gp;
#pragma unroll
                for (int r = 0; r < RB; ++r) { const float rstd = rsqrtf(ss[r] * (1.f / D) + EPS);
                    xv[r][j][0] += gg[0] * (bflo(yp[r][j].x) * rstd); xv[r][j][1] += gg[1] * (bfhi(yp[r][j].x) * rstd);
                    xv[r][j][2] += gg[2] * (bflo(yp[r][j].y) * rstd); xv[r][j][3] += gg[3] * (bfhi(yp[r][j].y) * rstd);
                    if (xd32) *(f32x4*)(xd32 + (row0 + r) * D + lane * 4 + 256 * j) = xv[r][j];
                    if (xd16) { u32x2 o; o.x = pk2(xv[r][j][0], xv[r][j][1]); o.y = pk2(xv[r][j][2], xv[r][j][3]);
                        *(u32x2*)(xd16 + (row0 + r) * D + lane * 4 + 256 * j) = o;
                        xv[r][j][0] = bflo(o.x); xv[r][j][1] = bfhi(o.x); xv[r][j][2] = bflo(o.y); xv[r][j][3] = bfhi(o.y); } } }
        }
        if (hout) {
            float ss[RB];
#pragma unroll
            for (int r = 0; r < RB; ++r) { ss[r] = 0.f;
#pragma unroll
                for (int j = 0; j < 4; ++j) ss[r] += (xv[r][j][0] * xv[r][j][0] + xv[r][j][1] * xv[r][j][1]) + (xv[r][j][2] * xv[r][j][2] + xv[r][j][3] * xv[r][j][3]); }
#pragma unroll
            for (int o = 1; o < 64; o <<= 1)
#pragma unroll
                for (int r = 0; r < RB; ++r) ss[r] += __shfl_xor(ss[r], o);
#pragma unroll
            for (int j = 0; j < 4; ++j) { const f32x4 sh = *(const f32x4*)(modb + modh + lane * 4 + 256 * j), scl = *(const f32x4*)(modb + modh + 1024 + lane * 4 + 256 * j), gp = *(const f32x4*)(gpre + lane * 4 + 256 * j);
                const f32x4 gs = gp * (scl + 1.f);
#pragma unroll
                for (int r = 0; r < RB; ++r) { const float rstd = rsqrtf(ss[r] * (1.f / D) + EPS);
                    u32x2 o; o.x = pk2(xv[r][j][0] * rstd * gs[0] + sh[0], xv[r][j][1] * rstd * gs[1] + sh[1]); o.y = pk2(xv[r][j][2] * rstd * gs[2] + sh[2], xv[r][j][3] * rstd * gs[3] + sh[3]);
                    *(u32x2*)(hout + (row0 + r) * LDH + lane * 4 + 256 * j) = o; } }
        }
    }
}

__device__ __forceinline__ void phase_convA(const Params& p, const bf16_t* bcv  , bf16_t* tout, const float* cw  ) {
    const int nthr = gridDim.x * 512;
    for (int id = opaque_bid() * 512 + opaque_tid(); id < 128 * 2048; id += nthr) {
        const int c8 = id & 127, rg = id >> 7;
        float w0[8], w1[8], w2[8];
#pragma unroll
        for (int h = 0; h < 2; ++h) { const f32x4 a = *(const f32x4*)(cw + c8 * 8 + h * 4), b = *(const f32x4*)(cw + 1024 + c8 * 8 + h * 4), c = *(const f32x4*)(cw + 2048 + c8 * 8 + h * 4);
#pragma unroll
            for (int i = 0; i < 4; ++i) { w0[h * 4 + i] = a[i]; w1[h * 4 + i] = b[i]; w2[h * 4 + i] = c[i]; } }
        const size_t r0 = (size_t)rg * 16;
        float cvm2[8], cvm1[8];
#pragma unroll
        for (int i = 0; i < 8; ++i) { cvm2[i] = 0.f; cvm1[i] = 0.f; }
        if ((r0 & 2047) != 0) {
            unpack8(*(const u32x4*)(bcv + (r0 - 2) * 2048 + 1024 + c8 * 8), cvm2);
            unpack8(*(const u32x4*)(bcv + (r0 - 1) * 2048 + 1024 + c8 * 8), cvm1);
        }
        u32x4 bq[4], cq[4];
#pragma unroll
        for (int q = 0; q < 4; ++q) { const bf16_t* rp = bcv + (r0 + q) * 2048 + c8 * 8; bq[q] = *(const u32x4*)rp; cq[q] = *(const u32x4*)(rp + 1024); }
#pragma unroll
        for (int bt = 0; bt < 4; ++bt) {
            u32x4 bn[4], cn[4];
            if (bt < 3) {
#pragma unroll
                for (int q = 0; q < 4; ++q) { const bf16_t* rp = bcv + (r0 + (bt + 1) * 4 + q) * 2048 + c8 * 8; bn[q] = *(const u32x4*)rp; cn[q] = *(const u32x4*)(rp + 1024); }
            }
#pragma unroll
            for (int q = 0; q < 4; ++q) {
                float bb[8], cv[8], o[8];
                unpack8(bq[q], bb); unpack8(cq[q], cv);
#pragma unroll
                for (int i = 0; i < 8; ++i) { o[i] = bb[i] * (w0[i] * cvm2[i] + w1[i] * cvm1[i] + w2[i] * cv[i]); cvm2[i] = cvm1[i]; cvm1[i] = cv[i]; }
                *(u32x4*)(tout + (r0 + bt * 4 + q) * LDH + c8 * 8) = pack8(o);
            }
            if (bt < 3) {
#pragma unroll
                for (int q = 0; q < 4; ++q) { bq[q] = bn[q]; cq[q] = cn[q]; }
            }
        }
    }
}

constexpr int L_C = 0, L_B = 17408, L_BT = 34816, L_XT = 53248, L_ST = 71680, L_CB = 106496, L_DT = 123904, L_CS = 124416, L_E1 = 124928, L_E2 = 125440;
constexpr int RS_CB = 272, RS_T = 144, RS_Y = 528;

__device__ __forceinline__ void load_raw(const bf16_t* base, int toff, bool first, int lrow, u32x4 (&raw)[5]) {
#pragma unroll
    for (int q = 0; q < 5; ++q) {
        if (!first || lrow - 3 + q >= 0) raw[q] = *(const u32x4*)(base + (q - 3) * LDZ + toff);
        else raw[q] = (u32x4){0u, 0u, 0u, 0u}; }
}
__device__ __forceinline__ void conv_rows(const u32x4 (&rawp)[5], const float* wl, float (&o0)[8], float (&o1)[8]) {
    float raw[5][8];
#pragma unroll
    for (int q = 0; q < 5; ++q) unpack8(rawp[q], raw[q]);
#pragma unroll
    for (int h = 0; h < 2; ++h) {
        const f32x4 bv = *(const f32x4*)(wl + 4 * 128 + h * 4);
        f32x4 a0 = bv, a1 = bv;
#pragma unroll
        for (int k = 0; k < 4; ++k) { const f32x4 wv = *(const f32x4*)(wl + k * 128 + h * 4);
#pragma unroll
            for (int i = 0; i < 4; ++i) { a0[i] += wv[i] * raw[k][h * 4 + i]; a1[i] += wv[i] * raw[k + 1][h * 4 + i]; } }
#pragma unroll
        for (int i = 0; i < 4; ++i) { o0[h * 4 + i] = silu_f(a0[i]); o1[h * 4 + i] = silu_f(a1[i]); }
        __builtin_amdgcn_sched_barrier(0);
    }
}

__device__ __forceinline__ void phase_ssd(const Params& p, uchar* sm, int j, bf16_t* zx, const float* dtraw, float* ssqb) {
    const int tid = opaque_tid(), w = tid >> 6, lane = tid & 63, l15 = lane & 15, quad = lane >> 4;
    const float* convw = p.m_conv_w + (size_t)j * 4 * CONVD; const float* convb = p.m_conv_b + (size_t)j * CONVD;
    const int c8 = tid & 15, lp = tid >> 4;
    const int chl = w * 16, rl = w >> 2;
    float* dtL = (float*)(sm + L_DT); float* csL = (float*)(sm + L_CS); float* e1L = (float*)(sm + L_E1); float* e2L = (float*)(sm + L_E2);
    for (int item = opaque_bid(); item < 256; item += gridDim.x) {
        const int bl = item >> 4, g = (item >> 1) & 7, hp = item & 1;
        const int headA = g * 4 + hp * 2;
        const int xch = g * 256 + hp * 128 + c8 * 8;
        float a_coef = 0.f, dtb = 0.f;
        const bool tabw = (w == 1 || w == 3); const int th = w >> 1;
        if (tabw) { a_coef = -__expf(p.m_a_log[j * 32 + headA + th]); dtb = p.m_dt_bias[j * 32 + headA + th]; }
        const float dskip = p.m_d[j * 32 + headA + (c8 >> 3)];
        f32x4 st[8];
#pragma unroll
        for (int n = 0; n < 8; ++n) st[n] = (f32x4){0.f, 0.f, 0.f, 0.f};
        const int bch = 2048 + g * 128 + c8 * 8, cch = 3072 + g * 128 + c8 * 8;
        const int swz = 4 * (c8 >> 1);
        u32x4 rx[5], rb[5], rc[5];
        {
            float* wl = (float*)(sm + LDS_WL);
            if (tid < 480) { const int t = tid / 160, k = (tid % 160) >> 5, c4 = tid & 31;
                const int ch = (t == 0 ? g * 256 + hp * 128 : (t == 1 ? 2048 + g * 128 : 3072 + g * 128)) + c4 * 4;
                *(f32x4*)(wl + (t * 5 + k) * 128 + c4 * 4) = *(const f32x4*)((k < 4 ? convw + (size_t)k * CONVD : convb) + ch); }
            __syncthreads();
        }
        const float* wlx = (const float*)(sm + LDS_WL) + c8 * 8; const float* wlb = wlx + 5 * 128; const float* wlc = wlx + 10 * 128;
        const int toff = (2 * lp) * LDZ + c8 * 8;
        const int colx = g * 256 + hp * 128, colb = 2048 + g * 128, colc = 3072 + g * 128;
        { const bf16_t* zb = zx + (size_t)bl * SEQ * LDZ;
          load_raw(zb + 2048 + colx, toff, true, 2 * lp, rx); load_raw(zb + 2048 + colb, toff, true, 2 * lp, rb); load_raw(zb + 2048 + colc, toff, true, 2 * lp, rc);
        }
        float dtr = 0.f;
        if (tabw) dtr = dtraw[((long)bl * SEQ + lane) * 32 + headA + th];
        for (int c = 0; c < 32; ++c) {
            const long zrow0 = (long)bl * SEQ + c * 64;
            float xo0[8], xo1[8];
            conv_rows(rx, wlx, xo0, xo1);
            __builtin_amdgcn_sched_barrier(0);
#pragma unroll
            for (int i = 0; i < 8; ++i) *(unsigned*)(sm + L_XT + (c8 * 8 + i) * RS_T + ((lp ^ swz) * 4)) = pk2(xo0[i], xo1[i]);
            {
                float t0[8], t1[8];
                __builtin_amdgcn_sched_barrier(0);
                conv_rows(rb, wlb, t0, t1);
                __builtin_amdgcn_sched_barrier(0);
                *(u32x4*)(sm + L_B + (2 * lp) * RS_CB + c8 * 16) = pack8(t0);
                *(u32x4*)(sm + L_B + (2 * lp + 1) * RS_CB + c8 * 16) = pack8(t1);
#pragma unroll
                for (int i = 0; i < 8; ++i) *(unsigned*)(sm + L_BT + (c8 * 8 + i) * RS_T + ((lp ^ swz) * 4)) = pk2(t0[i], t1[i]);
                __builtin_amdgcn_sched_barrier(0);
                conv_rows(rc, wlc, t0, t1);
                __builtin_amdgcn_sched_barrier(0);
                *(u32x4*)(sm + L_C + (2 * lp) * RS_CB + c8 * 16) = pack8(t0);
                *(u32x4*)(sm + L_C + (2 * lp + 1) * RS_CB + c8 * 16) = pack8(t1);
            }
            const u32x4 xp0 = pack8(xo0), xp1 = pack8(xo1);
            bf16_t* zc = zx + (size_t)zrow0 * LDZ;
            if (c + 1 < 32) { const bf16_t* zb = zc + 64 * LDZ;
                load_raw(zb + 2048 + colx, toff, false, 2 * lp, rx); }
            const u32x4 z0 = *(const u32x4*)(zc + colx + toff), z1 = *(const u32x4*)(zc + colx + LDZ + toff);
            __syncthreads();
            if (tabw) {
                const float v = dtr + dtb;
                const float dt = v > 20.f ? v : log1pf(__expf(v));
                float cs = dt * a_coef;
#pragma unroll
                for (int o = 1; o < 64; o <<= 1) { const float t = __shfl_up(cs, o); if (lane >= o) cs += t; }
                const float c63 = __shfl(cs, 63);
                dtL[th * 64 + lane] = dt; csL[th * 64 + lane] = cs; e1L[th * 64 + lane] = __expf(cs); e2L[th * 64 + lane] = dt * __expf(c63 - cs);
                if (c + 1 < 32) dtr = dtraw[(zrow0 + 64 + lane) * 32 + headA + th];
            } else {
                const int lt = w >> 1, st0 = (w & 1) * 2;
                f32x4 cacc[2] = {(f32x4){0.f, 0.f, 0.f, 0.f}, (f32x4){0.f, 0.f, 0.f, 0.f}};
#pragma unroll
                for (int ks = 0; ks < 4; ++ks) {
                    const bf16x8 a = *(const bf16x8*)(sm + L_C + (lt * 16 + l15) * RS_CB + (ks * 32 + quad * 8) * 2);
#pragma unroll
                    for (int q = 0; q < 2; ++q) { const bf16x8 b = *(const bf16x8*)(sm + L_B + ((st0 + q) * 16 + l15) * RS_CB + (ks * 32 + quad * 8) * 2);
                        cacc[q] = __builtin_amdgcn_mfma_f32_16x16x32_bf16(a, b, cacc[q], 0, 0, 0); }
                }
#pragma unroll
                for (int q = 0; q < 2; ++q)
#pragma unroll
                    for (int r = 0; r < 4; ++r) *(float*)(sm + L_CB + (lt * 16 + quad * 4 + r) * RS_CB + ((st0 + q) * 16 + l15) * 4) = cacc[q][r];
            }
            __syncthreads();
            {
                const int mq = w & 3; const int l = mq * 16 + l15; const float csl = csL[rl * 64 + l];
#pragma unroll
                for (int ks = 0; ks < 2; ++ks) {
                    if (ks == 1 && mq < 2) continue;
                    const f32x4 s0 = *(const f32x4*)(csL + rl * 64 + ks * 32 + quad * 8), s1 = *(const f32x4*)(csL + rl * 64 + ks * 32 + quad * 8 + 4);
                    const f32x4 c0 = *(const f32x4*)(sm + L_CB + l * RS_CB + (ks * 32 + quad * 8) * 4), c1 = *(const f32x4*)(sm + L_CB + l * RS_CB + (ks * 32 + quad * 8 + 4) * 4);
                    float mv[8];
#pragma unroll
                    for (int i = 0; i < 4; ++i) { const int sc = ks * 32 + quad * 8 + i;
                        mv[i] = (sc <= l) ? c0[i] * __expf(csl - s0[i]) : 0.f;
                        mv[4 + i] = (sc + 4 <= l) ? c1[i] * __expf(csl - s1[i]) : 0.f; }
                    *(u32x4*)(sm + LDS_MM + (rl * 64 + l) * RS_T + (ks * 32 + quad * 8) * 2) = pack8(mv);
                }
            }
            f32x4 yacc[4];
            {
                uchar* stw = sm + L_ST + w * (16 * RS_CB);
#pragma unroll
                for (int n = 0; n < 8; ++n) { u32x2 o; o.x = pk2(st[n][0], st[n][1]); o.y = pk2(st[n][2], st[n][3]);
                    *(u32x2*)(stw + l15 * RS_CB + (n * 16 + quad * 4) * 2) = o; }
#pragma unroll
                for (int m = 0; m < 4; ++m) yacc[m] = (f32x4){0.f, 0.f, 0.f, 0.f};
#pragma unroll
                for (int ks = 0; ks < 4; ++ks) {
                    const bf16x8 bfr = *(const bf16x8*)(stw + l15 * RS_CB + (ks * 32 + quad * 8) * 2);
#pragma unroll
                    for (int m = 0; m < 4; ++m) { const bf16x8 afr = *(const bf16x8*)(sm + L_C + (m * 16 + l15) * RS_CB + (ks * 32 + quad * 8) * 2);
                        yacc[m] = __builtin_amdgcn_mfma_f32_16x16x32_bf16(afr, bfr, yacc[m], 0, 0, 0); }
                }
#pragma unroll
                for (int m = 0; m < 4; ++m) { const f32x4 ev = *(const f32x4*)(e1L + rl * 64 + m * 16 + quad * 4);
#pragma unroll
                    for (int r = 0; r < 4; ++r) yacc[m][r] *= ev[r]; }
                const float cs63 = csL[rl * 64 + 63];
                bf16x8 xdt[2], xdd[2];
#pragma unroll
                for (int ks = 0; ks < 2; ++ks) {
                    float xr[8]; unpack8(*(const u32x4*)(sm + L_XT + (chl + l15) * RS_T + (((ks * 16 + quad * 4) ^ (4 * w)) * 4)), xr);
                    const f32x4 d0 = *(const f32x4*)(dtL + rl * 64 + ks * 32 + quad * 8), d1 = *(const f32x4*)(dtL + rl * 64 + ks * 32 + quad * 8 + 4);
                    const f32x4 g0 = *(const f32x4*)(e2L + rl * 64 + ks * 32 + quad * 8), g1 = *(const f32x4*)(e2L + rl * 64 + ks * 32 + quad * 8 + 4);
                    float a[8], b[8];
#pragma unroll
                    for (int i = 0; i < 4; ++i) { a[i] = xr[i] * d0[i]; a[4 + i] = xr[4 + i] * d1[i]; b[i] = xr[i] * g0[i]; b[4 + i] = xr[4 + i] * g1[i]; }
                    const u32x4 pa = pack8(a), pb = pack8(b);
                    xdt[ks] = __builtin_bit_cast(bf16x8, pa); xdd[ks] = __builtin_bit_cast(bf16x8, pb);
                }
                __syncthreads();
#pragma unroll
                for (int ks = 0; ks < 2; ++ks)
#pragma unroll
                    for (int m = 0; m < 4; ++m) {
                        if (ks == 1 && m < 2) continue;
                        const bf16x8 afr = *(const bf16x8*)(sm + LDS_MM + (rl * 64 + m * 16 + l15) * RS_T + (ks * 32 + quad * 8) * 2);
                        yacc[m] = __builtin_amdgcn_mfma_f32_16x16x32_bf16(afr, xdt[ks], yacc[m], 0, 0, 0);
                    }
                const float dec = e1L[rl * 64 + 63];
#pragma unroll
                for (int n = 0; n < 8; ++n) {
                    st[n] *= dec;
#pragma unroll
                    for (int ks = 0; ks < 2; ++ks) { const bf16x8 afr = *(const bf16x8*)(sm + L_BT + (n * 16 + l15) * RS_T + (((ks * 16 + quad * 4) ^ (4 * n)) * 4));
                        st[n] = __builtin_amdgcn_mfma_f32_16x16x32_bf16(afr, xdd[ks], st[n], 0, 0, 0); }
                }
            }
            if (c + 1 < 32) { load_raw(zc + 64 * LDZ + 2048 + colb, toff, false, 2 * lp, rb); load_raw(zc + 64 * LDZ + 2048 + colc, toff, false, 2 * lp, rc); }
            __syncthreads();
#pragma unroll
            for (int m = 0; m < 4; ++m)
#pragma unroll
                for (int r = 0; r < 4; ++r) *(float*)(sm + (m * 16 + quad * 4 + r) * RS_Y + (chl + l15) * 4) = yacc[m][r];
            __syncthreads();
            {
                float zf[8], o[8], xf[8];
                const f32x4 y0 = *(const f32x4*)(sm + (2 * lp) * RS_Y + c8 * 32), y1 = *(const f32x4*)(sm + (2 * lp) * RS_Y + c8 * 32 + 16);
                unpack8(z0, zf); unpack8(xp0, xf);
#pragma unroll
                for (int i = 0; i < 4; ++i) { o[i] = (y0[i] + dskip * xf[i]) * silu_f(zf[i]); o[4 + i] = (y1[i] + dskip * xf[4 + i]) * silu_f(zf[4 + i]); }
                *(u32x4*)(zc + colx + toff) = pack8(o);
                float q0 = 0.f;
#pragma unroll
                for (int i = 0; i < 8; ++i) q0 += o[i] * o[i];
                const f32x4 y2 = *(const f32x4*)(sm + (2 * lp + 1) * RS_Y + c8 * 32), y3 = *(const f32x4*)(sm + (2 * lp + 1) * RS_Y + c8 * 32 + 16);
                unpack8(z1, zf); unpack8(xp1, xf);
#pragma unroll
                for (int i = 0; i < 4; ++i) { o[i] = (y2[i] + dskip * xf[i]) * silu_f(zf[i]); o[4 + i] = (y3[i] + dskip * xf[4 + i]) * silu_f(zf[4 + i]); }
                *(u32x4*)(zc + colx + LDZ + toff) = pack8(o);
                float q1 = 0.f;
#pragma unroll
                for (int i = 0; i < 8; ++i) q1 += o[i] * o[i];
#pragma unroll
                for (int sft = 1; sft < 16; sft <<= 1) { q0 += __shfl_xor(q0, sft); q1 += __shfl_xor(q1, sft); }
                if (c8 == 0) { float* sq = ssqb + (size_t)(zrow0 + 2 * lp) * 16 + g * 2 + hp; sq[0] = q0; sq[16] = q1; }
            }
            __syncthreads();
        }
    }
}

__device__ __forceinline__ void phase_gnorm(bf16_t* yg, int ld, const float* ng) {
    const int tid = opaque_tid(), lane = tid & 63;
    const int gw = opaque_bid() * 8 + (tid >> 6), nw = gridDim.x * 8;
    for (int row = gw; row < M; row += nw) {
        bf16_t* rp = yg + (size_t)row * ld;
#pragma unroll
        for (int q = 0; q < 4; ++q) {
            const int ch = (lane + 64 * q) * 8;
            float v[8]; unpack8(*(const u32x4*)(rp + ch), v);
            float ss = 0.f;
#pragma unroll
            for (int i = 0; i < 8; ++i) ss += v[i] * v[i];
#pragma unroll
            for (int o = 1; o < 32; o <<= 1) ss += __shfl_xor(ss, o);
            const float rstd = rsqrtf(ss * (1.f / 256.f) + EPS);
            const f32x4 g0 = *(const f32x4*)(ng + ch), g1 = *(const f32x4*)(ng + ch + 4);
#pragma unroll
            for (int i = 0; i < 4; ++i) { v[i] = v[i] * rstd * g0[i]; v[4 + i] = v[4 + i] * rstd * g1[i]; }
            *(u32x4*)(rp + ch) = pack8(v);
        }
    }
}

__global__ void __launch_bounds__(512, 2) fwd_megakernel(Params p) {
    extern __shared__ __attribute__((aligned(16))) uchar smem[];
    cg::grid_group grid = cg::this_grid();
    int ph = 0;
    unsigned* barw = (unsigned*)(p.ws + WS_BAR);
    volatile LAS unsigned* bst = (volatile LAS unsigned*)(LAS uchar*)(smem + LDS_MAIN);
    if (threadIdx.x == 0) { bst[0] = 0u; bst[1] = 0u; }
    if (p.ph_hi - p.ph_lo > 1 && blockIdx.x == 0) for (int i = threadIdx.x; i < XCD_BAR_WORDS; i += 512) barw[i] = 0u;
    __syncthreads();
    XcdBarrier xb; xb.bar = barw; xb.x = 0u; xb.st = bst;
    bool posted = false;
#define GSYNC() do { if (!posted) { grid.sync(); xb = xcd_barrier_post(barw, bst); posted = true; } else xcd_barrier(xb); } while (0)
#ifndef DUP_GEMM
#define DUP_GEMM 1
#endif
#ifndef DUP_SSD
#define DUP_SSD 1
#endif
#ifndef DUP_SYNC
#define DUP_SYNC 1
#endif
#ifndef DUP_MISC
#define DUP_MISC 1
#endif
#define PHASE_N(n, body) do { if (ph >= p.ph_lo && ph < p.ph_hi) { for (int _r = 0; _r < (n); ++_r) { if (ph > p.ph_lo || _r) { for (int _s = 0; _s < DUP_SYNC; ++_s) GSYNC(); } body; } } ++ph; } while (0)
#define PHASE(body) PHASE_N(1, body)
    bf16_t* hy = (bf16_t*)p.out;
    bf16_t* xres = (bf16_t*)(p.ws + WS_XB); bf16_t* ylast = (bf16_t*)(p.ws + WS_YL);
    const bf16_t* wmix = (const bf16_t*)(p.ws + WS_WMIX); const bf16_t* wffn = (const bf16_t*)(p.ws + WS_WFFN);
    PHASE_N(DUP_MISC, phase_prologue(p, smem));
#pragma unroll 1
    for (int jp = 0; jp < 2; ++jp) {
#pragma unroll 1
        for (int kind = 0; kind < 2; ++kind) {
            const int i = 2 * jp + kind;
            const float* ng = p.norm_g + (size_t)i * 4 * D;
            const int modi = i * 6 * D;
            if (i == 0) PHASE(phase_rowwise(p, p.x, nullptr, nullptr, nullptr, nullptr, nullptr, 0, hy, ng, modi));
            else PHASE({ phase_rowwise(p, nullptr, xres, nullptr, xres, hy, p.norm_g + (size_t)((i - 1) * 4 + 3) * D, (i - 1) * 6 * D + 5 * D, hy, ng, modi); convert_layer_weights(p, smem, i, false, true); });
            if (kind == 0) {
                bf16_t* bcv = (bf16_t*)(p.ws + WS_BCV); bf16_t* tb = (bf16_t*)(p.ws + WS_T);
                PHASE_N(DUP_GEMM, run_gemm(smem, hy, LDH, wmix, LDW1, M, 3072, 1024, EpiBCV{bcv}));
                PHASE_N(DUP_MISC, phase_convA(p, bcv, tb, p.a_conv_w + (size_t)jp * 3 * D));
                PHASE_N(DUP_GEMM, run_gemm(smem, tb, LDH, (const bf16_t*)(p.ws + WS_WMIX + OFF_W2), LDW1, M, 1024, 1024, EpiStoreBf16{hy, LDH}));
            } else {
                bf16_t* zx = (bf16_t*)(p.ws + WS_ZX); float* dtr = (float*)(p.ws + WS_DTR);
                PHASE_N(DUP_GEMM, run_gemm(smem, hy, LDH, wmix, LDW1, M, MIN_NP, 1024, EpiSSDIn{zx, dtr}));
                float* ssqb = (float*)(p.ws + WS_SSQ);
                PHASE_N(DUP_SSD, phase_ssd(p, smem, jp, zx, dtr, ssqb));
                PHASE_N(DUP_GEMM, run_gemm(smem, zx, LDZ, (const bf16_t*)(p.ws + WS_WMIX + OFF_W2), LDW2, M, 1024, 2048, EpiStoreGroupNorm{hy, LDH, smem}, ssqb));
            }
            PHASE({ phase_rowwise(p, i == 0 ? p.x : nullptr, xres, nullptr, xres, hy, ng + D, modi + 2 * D, hy, ng + 2 * D, modi + 3 * D); if (i < 3) convert_layer_weights(p, smem, i + 1, true, false); });
            bf16_t* act = (bf16_t*)(p.ws + WS_ACT);
            PHASE_N(DUP_GEMM, run_gemm(smem, hy, LDH, wffn, LDW1, M, 5632, 1024, EpiSwiGLU{act}));
            PHASE_N(DUP_GEMM, run_gemm(smem, act, DFF, (const bf16_t*)(p.ws + WS_WFFN + OFF_F2), DFF, M, 1024, DFF, EpiStoreBf16{i == 3 ? ylast : hy, LDH}));
        }
    }
    PHASE(phase_rowwise(p, nullptr, xres, p.out, nullptr, ylast, p.norm_g + (size_t)(3 * 4 + 3) * D, 3 * 6 * D + 5 * D, nullptr, nullptr, 0));
#undef PHASE
#undef PHASE_N
#undef GSYNC
}
constexpr int NPHASES = 1 + 2 * (1 + 3 + 1 + 2) + 2 * (1 + 3 + 1 + 2) + 1;

extern "C" void kernel_launch(void* const* d_in, const int* in_sizes, int n_in, void* d_out, int out_size, void* d_ws, size_t ws_size, hipStream_t stream) {
    static int grid = 0;
    if (grid == 0) {
        if (n_in != 18 || out_size != M * D || ws_size < WS_END) { fprintf(stderr, "kernel_launch: unexpected problem (n_in %d out %d ws %zu need %zu)\n", n_in, out_size, ws_size, (size_t)WS_END); grid = -1; return; }
        int dev = 0, cus = 0, per_cu = 0;
        hipGetDevice(&dev); hipDeviceGetAttribute(&cus, hipDeviceAttributeMultiprocessorCount, dev);
        if (hipFuncSetAttribute((const void*)fwd_megakernel, hipFuncAttributeMaxDynamicSharedMemorySize, LDS_BYTES) != hipSuccess) { fprintf(stderr, "kernel_launch: hipFuncSetAttribute failed\n"); grid = -1; return; }
        hipOccupancyMaxActiveBlocksPerMultiprocessor(&per_cu, (const void*)fwd_megakernel, 512, LDS_BYTES);
        (void)hipGetLastError();
        if (per_cu < 1) per_cu = 1;
        grid = cus * 1;
        fprintf(stderr, "kernel_launch: cus %d per_cu %d grid %d phases %d\n", cus, per_cu, grid, NPHASES);
    }
    if (grid < 0) return;
    Params p{};
    const float** pp = (const float**)&p;
    for (int i = 0; i < 18; ++i) pp[i] = (const float*)d_in[i];
    p.out = (float*)d_out; p.ws = (uchar*)d_ws;
#if COOP
    p.ph_lo = 0; p.ph_hi = NPHASES;
    void* args[] = {&p};
    hipError_t e = hipLaunchCooperativeKernel((const void*)fwd_megakernel, dim3(grid), dim3(512), args, LDS_BYTES, stream);
    if (e != hipSuccess) fprintf(stderr, "cooperative launch failed: %s (grid %d)\n", hipGetErrorString(e), grid);
#else
    for (int ph = 0; ph < NPHASES; ++ph) {
        p.ph_lo = ph; p.ph_hi = ph + 1;
        hipLaunchKernelGGL(fwd_megakernel, dim3(grid), dim3(512), LDS_BYTES, stream, p);
    }
#endif
}
```

```cpp
#include <hip/hip_runtime.h>
#include <hip/hip_cooperative_groups.h>
#include <cstdio>
namespace cg = cooperative_groups;

#ifndef COOP
#define COOP 1
#endif

typedef unsigned char uchar;
typedef unsigned short bf16_t;
typedef short bf16x8 __attribute__((ext_vector_type(8)));
typedef float f32x4 __attribute__((ext_vector_type(4)));
typedef float f32x2 __attribute__((ext_vector_type(2)));
typedef unsigned u32x4 __attribute__((ext_vector_type(4)));
typedef unsigned u32x2 __attribute__((ext_vector_type(2)));
#define LAS __attribute__((address_space(3)))

constexpr int D = 1024, NB = 16, SEQ = 2048, M = NB * SEQ, DFF = 2816, DI = 2048, NHEAD = 32;
constexpr int CONVD = 4096, MIN_N = 6176, MIN_NP = 6400, ZXC = 6144, NMODV = 24576;
constexpr int LDH = 1088, LDZ = 6208, LDW1 = 1088, LDW2 = 2112;
constexpr int MH = M / 2;
constexpr float EPS = 1e-6f;
constexpr int LDS_MAIN = 131072;
constexpr int LDS_RT = LDS_MAIN + 256;
constexpr int LDS_MM = LDS_RT;
constexpr int LDS_WL = LDS_RT + 2 * 64 * 144;
constexpr int LDS_BYTES = LDS_WL + 3 * 5 * 128 * 4;

constexpr size_t WS_BAR   = 0;
constexpr size_t WS_MOD   = 16384;
constexpr size_t SZ_AWIN  = (size_t)3072 * 1024 * 2;
constexpr size_t SZ_AWOUT = (size_t)1024 * 1024 * 2;
constexpr size_t SZ_MWIN  = (size_t)MIN_NP * 1024 * 2;
constexpr size_t SZ_MWOUT = (size_t)1024 * 2048 * 2;
constexpr size_t SZ_FWIN  = (size_t)5632 * 1024 * 2;
constexpr size_t SZ_FWOUT = (size_t)1024 * 2816 * 2;
constexpr size_t OFF_W2   = (size_t)MIN_NP * LDW1 * 2;
constexpr size_t SZ_WMIX  = OFF_W2 + (size_t)1024 * LDW2 * 2;
constexpr size_t OFF_F2   = (size_t)5632 * LDW1 * 2;
constexpr size_t SZ_WFFN  = OFF_F2 + (size_t)1024 * 2816 * 2;
constexpr size_t WS_WMIX  = WS_MOD + (size_t)NB * NMODV * 4;
constexpr size_t WS_WFFN  = WS_WMIX + SZ_WMIX;
constexpr size_t WS_XB    = WS_WFFN + SZ_WFFN;
constexpr size_t WS_S     = WS_XB + (size_t)M * 1024 * 2;
constexpr size_t WS_BCV   = WS_S;
constexpr size_t WS_T     = WS_BCV + (size_t)M * 3072 * 2;
constexpr size_t WS_ZX    = WS_S;
constexpr size_t WS_DTR   = WS_ZX + (size_t)M * LDZ * 2;
constexpr size_t WS_SSQ   = WS_DTR + (size_t)M * 32 * 4;
constexpr size_t WS_SSD_END = WS_SSQ + (size_t)M * 16 * 4;
constexpr size_t WS_ACT   = WS_S;
constexpr size_t WS_YL    = WS_S + (size_t)M * 3072 * 2;
constexpr size_t WS_END   = WS_SSD_END;
static_assert(WS_T + (size_t)M * LDH * 2 <= WS_END && WS_YL + (size_t)M * LDH * 2 <= WS_END && WS_END <= ((size_t)512 << 20), "workspace map");

struct Params {
    const float *x, *c, *ada_w, *ada_b, *norm_g, *a_w_in, *a_conv_w, *a_w_out, *m_w_in, *m_conv_w, *m_conv_b, *m_dt_bias, *m_a_log, *m_d, *m_norm_g, *m_w_out, *f_w_in, *f_w_out;
    float* out; uchar* ws; int ph_lo, ph_hi;
};

__device__ __forceinline__ unsigned pk2(float lo, float hi) { unsigned r; asm("v_cvt_pk_bf16_f32 %0, %1, %2" : "=v"(r) : "v"(lo), "v"(hi)); return r; }
__device__ __forceinline__ float bflo(unsigned u) { return __uint_as_float(u << 16); }
__device__ __forceinline__ float bfhi(unsigned u) { return __uint_as_float(u & 0xffff0000u); }
__device__ __forceinline__ void unpack8(const u32x4 v, float (&o)[8]) {
    o[0] = bflo(v.x); o[1] = bfhi(v.x); o[2] = bflo(v.y); o[3] = bfhi(v.y); o[4] = bflo(v.z); o[5] = bfhi(v.z); o[6] = bflo(v.w); o[7] = bfhi(v.w);
}
__device__ __forceinline__ u32x4 pack8(const float (&o)[8]) { u32x4 r; r.x = pk2(o[0], o[1]); r.y = pk2(o[2], o[3]); r.z = pk2(o[4], o[5]); r.w = pk2(o[6], o[7]); return r; }
__device__ __forceinline__ float wave_sum(float v) {
#pragma unroll
    for (int o = 1; o < 64; o <<= 1) v += __shfl_xor(v, o);
    return v;
}
__device__ __forceinline__ float wave_incl_scan(float v) {
#define DPP_ADD(ctrl, rmask) do { const int _t = __builtin_amdgcn_update_dpp(0, __float_as_int(v), ctrl, rmask, 0xf, false); v += __int_as_float(_t); } while (0)
    DPP_ADD(0x111, 0xf); DPP_ADD(0x112, 0xf); DPP_ADD(0x114, 0xf); DPP_ADD(0x118, 0xf); DPP_ADD(0x142, 0xa); DPP_ADD(0x143, 0xc);
#undef DPP_ADD
    return v;
}
__device__ __forceinline__ int opaque_tid() { int t = threadIdx.x; asm volatile("" : "+v"(t)); return t; }
__device__ __forceinline__ int opaque_bid() { int b = blockIdx.x; asm volatile("" : "+s"(b)); return b; }
__device__ __forceinline__ float silu_f(float v) { return v * __builtin_amdgcn_rcpf(1.f + __expf(-v)); }


#define XB_TMO      128
#define XB_XCNT(j)  (256  + 64 * (j))
#define XB_XSUB(j)  (1280 + 64 * (j))
#define XB_XGEN(j)  (2304 + 64 * (j))
#define XB_TOP      3328
#define XB_TOPGEN   3392
#define XCD_BAR_WORDS 3456
#define XB_SPIN_CAP (1u << 22)
__device__ __forceinline__ unsigned xb_ld(unsigned* p)              { return __hip_atomic_load(p, __ATOMIC_RELAXED, __HIP_MEMORY_SCOPE_AGENT); }
__device__ __forceinline__ unsigned xb_add(unsigned* p, unsigned v) { return __hip_atomic_fetch_add(p, v, __ATOMIC_RELAXED, __HIP_MEMORY_SCOPE_AGENT); }
__device__ __forceinline__ unsigned xb_xcc_id() { return (unsigned)__builtin_amdgcn_s_getreg((3 << 11) | 20) & 0xFu; }
#define XB_SPIN(cond, bar) do { unsigned _sp = 0; while (cond) { __builtin_amdgcn_s_sleep(1); \
    if ((++_sp & 255u) == 0u) { if (xb_ld(&(bar)[XB_TMO])) break; if (_sp > XB_SPIN_CAP) { atomicAdd(&(bar)[XB_TMO], 1u); break; } } } } while (0)
struct XcdBarrier { unsigned* bar; unsigned x; volatile LAS unsigned* st; };
__device__ __forceinline__ XcdBarrier xcd_barrier_post(unsigned* bar, volatile LAS unsigned* st) {
    XcdBarrier b; b.bar = bar; b.x = xb_xcc_id(); b.st = st;
    if (threadIdx.x == 0) (void)xb_add(&bar[XB_XCNT(b.x)], 1u);
    return b;
}
__device__ __forceinline__ void xcd_barrier_complete(unsigned* bar, unsigned x, unsigned& nloc, unsigned& nx) {
    const unsigned G = gridDim.x * gridDim.y * gridDim.z;
    unsigned sum, cnt, mine, sp = 0u;
    for (;;) {
        sum = 0u; cnt = 0u; mine = 0u;
#pragma unroll
        for (unsigned j = 0; j < 16; ++j) { const unsigned c = xb_ld(&bar[XB_XCNT(j)]); sum += c; cnt += (c > 0u) ? 1u : 0u; mine = (j == x) ? c : mine; }
        if (sum == G) break;
        __builtin_amdgcn_s_sleep(1);
        if ((++sp & 255u) == 0u) { if (xb_ld(&bar[XB_TMO])) break; if (sp > XB_SPIN_CAP) { atomicAdd(&bar[XB_TMO], 1u); break; } }
    }
    nloc = mine > 0u ? mine : 1u; nx = cnt > 0u ? cnt : 1u;
}
__device__ __forceinline__ void xcd_barrier(const XcdBarrier& b) {
    asm volatile("s_waitcnt vmcnt(0)" ::: "memory");
    __syncthreads();
    if (threadIdx.x == 0) {
        unsigned* bar = b.bar;
        __builtin_amdgcn_s_waitcnt(0);
        unsigned nloc = b.st[0], nx = b.st[1];
        if (nloc == 0u) { xcd_barrier_complete(bar, b.x, nloc, nx); b.st[0] = nloc; b.st[1] = nx; }
        const unsigned old = xb_add(&bar[XB_XSUB(b.x)], 1u);
        const unsigned gen = old / nloc;
        if (old + 1u == (gen + 1u) * nloc) {
            __builtin_amdgcn_fence(__ATOMIC_RELEASE, "agent");
            asm volatile("s_waitcnt vmcnt(0)" ::: "memory");
            const unsigned og = xb_add(&bar[XB_TOP], 1u);
            const unsigned tg = og / nx;
            if (og + 1u == (tg + 1u) * nx) xb_add(&bar[XB_TOPGEN], 1u);
            else XB_SPIN(xb_ld(&bar[XB_TOPGEN]) == tg, bar);
            __builtin_amdgcn_fence(__ATOMIC_ACQUIRE, "agent");
            xb_add(&bar[XB_XGEN(b.x)], 1u);
            asm volatile("s_waitcnt vmcnt(0)" ::: "memory");
        } else {
            XB_SPIN(xb_ld(&bar[XB_XGEN(b.x)]) == gen, bar);
            __builtin_amdgcn_fence(__ATOMIC_ACQUIRE, "agent");
            asm volatile("s_waitcnt vmcnt(0)" ::: "memory");
        }
    }
    __syncthreads();
}

namespace pg8 {
constexpr int BM = 256, BK = 64, HALF = 128, HTB = HALF * BK * 2, STAGE_BYTES = 8 * HTB, NXCD = 8, WGM = 8;
__device__ __forceinline__ int lds_byte(int r, int c) { const int st = (r >> 4) * 2 + (c >> 5), rr = r & 15, cc = c & 31, ob = rr * 64 + cc * 2; return st * 1024 + (ob ^ (((ob >> 9) & 1) << 5)); }
__device__ __forceinline__ void stage_rc(int b, int& R, int& C) { const int st = b / 1024, sb = b % 1024, swz = sb ^ (((sb >> 9) & 1) << 5); R = (st >> 1) * 16 + swz / 64; C = (st & 1) * 32 + (swz % 64) / 2; }
__device__ __forceinline__ int perm32(int rho) { const int n = rho >> 4, i = rho & 15; return 8 * (i >> 2) + 4 * n + (i & 3); }
struct Unit { int pm, pn; };
struct Gemm { const bf16_t* A; const bf16_t* Bt; int M, N, K, lda, ldb; const float* ssq; };
struct StaticOrder {
    int nM, nN, nwg, G, c;
    __device__ void init(int M_, int N_, int G_, int c_) { nM = M_ / BM; nN = N_ / BM; nwg = nM * nN; G = G_; c = c_; }
    __device__ bool next(int i, Unit& u) const {
        const long L = (long)i * G + c; if (L >= nwg) return false;
        int wgid = (int)L; { const int q = nwg / NXCD, r = nwg % NXCD, xcd = wgid % NXCD, off = wgid / NXCD; wgid = (xcd < r ? xcd * (q + 1) : r * (q + 1) + (xcd - r) * q) + off; }
        const int nig = WGM * nN, gid = wgid / nig, fm = gid * WGM, gsz = (nM - fm) < WGM ? (nM - fm) : WGM;
        u.pm = fm + ((wgid % nig) % gsz); u.pn = (wgid % nig) / gsz; return true;
    }
};

#ifndef PG8_SP2
#define PG8_SP2 true
#endif
#ifndef PG8_ALIGN
#define PG8_ALIGN true
#endif
template <class Epi, bool ALIGN_EPI = PG8_ALIGN, bool SP2 = PG8_SP2>
__device__ __forceinline__ void gemm_phase(LAS uchar* lds, const Gemm g, const StaticOrder& S, const Epi& E) {
    const int tid = opaque_tid(), wid = __builtin_amdgcn_readfirstlane(tid >> 6), lane = tid & 63, wr = wid >> 2, wc = wid & 3, fr = lane & 15, fq = lane >> 4;
    const int K = g.K, nt = K / BK;
    unsigned voffA[2], voffB[2];
#pragma unroll
    for (int i = 0; i < 2; ++i) { int R, C; stage_rc(tid * 16 + i * 8192, R, C); const int Rb = (R & ~31) + perm32(R & 31);
        voffA[i] = (unsigned)(R * g.lda + C) * 2u; voffB[i] = (unsigned)(Rb * g.ldb + C) * 2u; }
    const size_t kstep = (size_t)(BK * 2);
    const size_t hstepB = (size_t)HALF * g.ldb * 2, hstepA = (size_t)HALF * g.lda * 2;
    const size_t tstepB = 2 * hstepB, tstepA = 2 * hstepA;
    const unsigned ldsw = (unsigned)wid * 1024u;
    const int aoff = lds_byte(wr * 64 + fr, fq * 8), boff = lds_byte(wc * 32 + fr, fq * 8);
#define PG8_SA(b, h) (((b) * 2 + (h)) * HTB)
#define PG8_SB(b, h) ((4 + (b) * 2 + (h)) * HTB)
#define PG8_STAGE(bufoff, gbase, voff) do { _Pragma("unroll") for (int _i = 0; _i < 2; ++_i) \
        __builtin_amdgcn_global_load_lds((const unsigned*)((const char*)(gbase) + (voff)[_i]), (LAS unsigned*)(lds + (bufoff) + ldsw + _i * 8192), 16, 0, 0); } while (0)
#define PG8_LDA(dst, b, h) do { _Pragma("unroll") for (int m = 0; m < 4; ++m) _Pragma("unroll") for (int k = 0; k < 2; ++k) dst[m][k] = *(const LAS bf16x8*)(lds + PG8_SA(b, h) + aoff + m * 2048 + k * 1024); } while (0)
#define PG8_LDB(dst, b, h) do { _Pragma("unroll") for (int n = 0; n < 2; ++n) _Pragma("unroll") for (int k = 0; k < 2; ++k) dst[n][k] = *(const LAS bf16x8*)(lds + PG8_SB(b, h) + boff + n * 2048 + k * 1024); } while (0)
#define PG8_MMA(ai, bj, At, Bt) do { __builtin_amdgcn_s_setprio(1); _Pragma("unroll") for (int m = 0; m < 4; ++m) _Pragma("unroll") for (int n = 0; n < 2; ++n) _Pragma("unroll") for (int k = 0; k < 2; ++k) \
        acc[ai][bj][m][n] = __builtin_amdgcn_mfma_f32_16x16x32_bf16(Bt[n][k], At[m][k], acc[ai][bj][m][n], 0, 0, 0); __builtin_amdgcn_s_setprio(0); } while (0)
#define PG8_WAIT_V(n) asm volatile("s_waitcnt vmcnt(" #n ")" ::: "memory")
#define PG8_WAIT_L(n) asm volatile("s_waitcnt lgkmcnt(" #n ")" ::: "memory")
#define PG8_BAR __builtin_amdgcn_s_barrier()
#define PG8_SCHED __builtin_amdgcn_sched_barrier(0)
    Unit cur, nxt; int ui = 0;
    if constexpr (Epi::GROUPS) {
        LAS float* rt = (LAS float*)(lds + LDS_RT);
#pragma unroll 1
        for (int u = 0; u < 2; ++u) { Unit uu; if (!S.next(u, uu)) break;
            if (tid < 256) { const float* sp = g.ssq + (size_t)(uu.pm * 256 + tid) * 16; float r[8];
#pragma unroll
                for (int q = 0; q < 8; ++q) r[q] = rsqrtf((sp[2 * q] + sp[2 * q + 1]) * (1.f / 256.f) + EPS);
#pragma unroll
                for (int q = 0; q < 8; ++q) rt[(u * 256 + tid) * 8 + q] = (q < 7) ? r[q] * __builtin_amdgcn_rcpf(r[q + 1]) : r[7]; } }
        __syncthreads();
    }
    if (!S.next(0, cur)) return;
    f32x4 acc[2][2][4][2];
#pragma unroll
    for (int a = 0; a < 2; ++a)
#pragma unroll
        for (int b = 0; b < 2; ++b)
#pragma unroll
            for (int m = 0; m < 4; ++m)
#pragma unroll
                for (int n = 0; n < 2; ++n) acc[a][b][m][n] = (f32x4){0.f, 0.f, 0.f, 0.f};
    bf16x8 At[4][2], B0[2][2], B1[2][2];
    const char* cA = (const char*)g.A + (size_t)cur.pm * tstepA; const char* cB = (const char*)g.Bt + (size_t)cur.pn * tstepB;
    if constexpr (SP2) {
        PG8_STAGE(PG8_SB(0, 0), cB, voffB); PG8_STAGE(PG8_SB(0, 1), cB + hstepB, voffB); PG8_STAGE(PG8_SA(0, 0), cA, voffA); PG8_STAGE(PG8_SA(0, 1), cA + hstepA, voffA);
        if (wr == 1) PG8_BAR;
        PG8_WAIT_V(2); PG8_BAR;
        PG8_STAGE(PG8_SB(1, 0), cB + kstep, voffB); PG8_STAGE(PG8_SA(1, 0), cA + kstep, voffA); PG8_STAGE(PG8_SB(1, 1), cB + hstepB + kstep, voffB);
        PG8_WAIT_V(6); PG8_BAR;
    } else {
    PG8_STAGE(PG8_SB(0, 0), cB, voffB); PG8_STAGE(PG8_SA(0, 0), cA, voffA); PG8_STAGE(PG8_SB(0, 1), cB + hstepB, voffB); PG8_STAGE(PG8_SA(0, 1), cA + hstepA, voffA);
    if (wr == 1) PG8_BAR;
    PG8_WAIT_V(4); PG8_BAR;
    PG8_STAGE(PG8_SB(1, 0), cB + kstep, voffB); PG8_STAGE(PG8_SA(1, 0), cA + kstep, voffA); PG8_STAGE(PG8_SB(1, 1), cB + hstepB + kstep, voffB);
    PG8_WAIT_V(6); PG8_BAR;
    }
    for (;;) {
        const bool has_next = S.next(ui + 1, nxt);
        const char* nA = has_next ? (const char*)g.A + (size_t)nxt.pm * tstepA : cA; const char* nB = has_next ? (const char*)g.Bt + (size_t)nxt.pn * tstepB : cB;
        const int tblk = Epi::GROUPS ? 4 : nt;
#pragma unroll 1
        for (int tb = 0; tb < nt; tb += tblk) {
        if constexpr (Epi::GROUPS) { if (tb > 0) {
            const LAS float* rt = (const LAS float*)(lds + LDS_RT) + ((ui & 1) * 256 + wr * 64 + fr) * 8 + ((tb >> 2) - 1);
#pragma unroll
            for (int a = 0; a < 2; ++a)
#pragma unroll
                for (int m = 0; m < 4; ++m) { const float f = rt[(a * 128 + m * 16) * 8];
#pragma unroll
                    for (int b = 0; b < 2; ++b)
#pragma unroll
                        for (int n = 0; n < 2; ++n) acc[a][b][m][n] *= f; } } }
#pragma unroll 1
        for (int t = tb; t < tb + tblk; t += 2) {
            const bool last = (t == nt - 2);
            const char* a1 = cA + (size_t)(t + 1) * kstep;
            const char* a2 = last ? nA : cA + (size_t)(t + 2) * kstep; const char* b2 = last ? nB : cB + (size_t)(t + 2) * kstep;
            const char* a3 = a2 + kstep; const char* b3 = b2 + kstep;
            if constexpr (SP2) {
            PG8_LDB(B0, 0, 0); PG8_LDB(B1, 0, 1); PG8_SCHED; PG8_LDA(At, 0, 0); PG8_STAGE(PG8_SA(1, 1), a1 + hstepA, voffA);
            PG8_WAIT_V(8); PG8_WAIT_L(0); PG8_BAR; PG8_MMA(0, 0, At, B0); PG8_MMA(0, 1, At, B1); PG8_BAR; PG8_SCHED;
            PG8_LDA(At, 0, 1); PG8_STAGE(PG8_SB(0, 0), b2, voffB); PG8_STAGE(PG8_SB(0, 1), b2 + hstepB, voffB); PG8_STAGE(PG8_SA(0, 0), a2, voffA);
            PG8_WAIT_V(8); PG8_WAIT_L(0); PG8_BAR; PG8_MMA(1, 0, At, B0); PG8_MMA(1, 1, At, B1); PG8_BAR; PG8_SCHED;
            PG8_LDB(B0, 1, 0); PG8_LDB(B1, 1, 1); PG8_SCHED; PG8_LDA(At, 1, 0); PG8_STAGE(PG8_SA(0, 1), a2 + hstepA, voffA);
            PG8_WAIT_V(8); PG8_WAIT_L(0); PG8_BAR; PG8_MMA(0, 0, At, B0); PG8_MMA(0, 1, At, B1); PG8_BAR; PG8_SCHED;
            PG8_LDA(At, 1, 1); PG8_STAGE(PG8_SB(1, 0), b3, voffB); PG8_STAGE(PG8_SB(1, 1), b3 + hstepB, voffB); PG8_STAGE(PG8_SA(1, 0), a3, voffA);
            PG8_WAIT_V(8); PG8_WAIT_L(0); PG8_BAR; PG8_MMA(1, 0, At, B0); PG8_MMA(1, 1, At, B1); PG8_BAR; PG8_SCHED;
            } else {
            PG8_LDB(B0, 0, 0); PG8_SCHED; PG8_LDA(At, 0, 0); PG8_STAGE(PG8_SA(1, 1), a1 + hstepA, voffA);
            PG8_WAIT_L(8); PG8_BAR; PG8_WAIT_L(0); PG8_MMA(0, 0, At, B0); PG8_BAR; PG8_SCHED;
            PG8_LDB(B1, 0, 1); PG8_STAGE(PG8_SB(0, 0), b2, voffB);
            PG8_BAR; PG8_WAIT_L(0); PG8_MMA(0, 1, At, B1); PG8_BAR;
            PG8_LDA(At, 0, 1); PG8_STAGE(PG8_SA(0, 0), a2, voffA);
            PG8_BAR; PG8_WAIT_L(0); PG8_MMA(1, 0, At, B0); PG8_BAR; PG8_SCHED;
            PG8_STAGE(PG8_SB(0, 1), b2 + hstepB, voffB);
            PG8_WAIT_V(6); PG8_BAR; PG8_MMA(1, 1, At, B1); PG8_BAR;
            PG8_LDB(B0, 1, 0); PG8_SCHED; PG8_LDA(At, 1, 0); PG8_STAGE(PG8_SA(0, 1), a2 + hstepA, voffA);
            PG8_WAIT_L(8); PG8_BAR; PG8_WAIT_L(0); PG8_MMA(0, 0, At, B0); PG8_BAR; PG8_SCHED;
            PG8_LDB(B1, 1, 1); PG8_STAGE(PG8_SB(1, 0), b3, voffB);
            PG8_BAR; PG8_WAIT_L(0); PG8_MMA(0, 1, At, B1); PG8_BAR;
            PG8_LDA(At, 1, 1); PG8_STAGE(PG8_SA(1, 0), a3, voffA);
            PG8_BAR; PG8_WAIT_L(0); PG8_MMA(1, 0, At, B0); PG8_BAR; PG8_SCHED;
            PG8_STAGE(PG8_SB(1, 1), b3 + hstepB, voffB);
            PG8_WAIT_V(6); PG8_BAR; PG8_MMA(1, 1, At, B1); PG8_BAR;
            }
        }
        }
        if constexpr (ALIGN_EPI) { if (wr == 0) PG8_BAR; }
        E(acc, cur, wr, wc, fr, fq, ui);
        if (!has_next) break;
#pragma unroll
        for (int a = 0; a < 2; ++a)
#pragma unroll
            for (int b = 0; b < 2; ++b)
#pragma unroll
                for (int m = 0; m < 4; ++m)
#pragma unroll
                    for (int n = 0; n < 2; ++n) acc[a][b][m][n] = (f32x4){0.f, 0.f, 0.f, 0.f};
        cur = nxt; cA = nA; cB = nB; ++ui;
        if constexpr (ALIGN_EPI) { if (wr == 1) PG8_BAR; }
    }
    PG8_WAIT_V(0);
    if constexpr (!ALIGN_EPI) { if (wr == 0) PG8_BAR; }
    PG8_BAR;
#undef PG8_SA
#undef PG8_SB
#undef PG8_STAGE
#undef PG8_LDA
#undef PG8_LDB
#undef PG8_MMA
#undef PG8_WAIT_V
#undef PG8_WAIT_L
#undef PG8_BAR
#undef PG8_SCHED
}
}

struct EpiStoreBf16 {
    static constexpr bool GROUPS = false;
    bf16_t* O; int ldc;
    __device__ __forceinline__ void operator()(const f32x4 (&acc)[2][2][4][2], const pg8::Unit& u, int wr, int wc, int fr, int fq, int) const {
        const int row0 = u.pm * 256 + wr * 64 + fr, col0 = u.pn * 256 + wc * 32 + 8 * fq;
#pragma unroll
        for (int ai = 0; ai < 2; ++ai)
#pragma unroll
            for (int m = 0; m < 4; ++m) { bf16_t* rowp = O + (size_t)(row0 + ai * 128 + m * 16) * ldc + col0;
#pragma unroll
                for (int bj = 0; bj < 2; ++bj) { const f32x4 v0 = acc[ai][bj][m][0], v1 = acc[ai][bj][m][1];
                    u32x4 o; o.x = pk2(v0[0], v0[1]); o.y = pk2(v0[2], v0[3]); o.z = pk2(v1[0], v1[1]); o.w = pk2(v1[2], v1[3]);
                    *(u32x4*)(rowp + bj * 128) = o; } }
    }
};
struct EpiStoreGroupNorm {
    static constexpr bool GROUPS = true;
    bf16_t* O; int ldc; const uchar* lds;
    __device__ __forceinline__ void operator()(const f32x4 (&acc)[2][2][4][2], const pg8::Unit& u, int wr, int wc, int fr, int fq, int ui) const {
        const int row0 = u.pm * 256 + wr * 64 + fr, col0 = u.pn * 256 + wc * 32 + 8 * fq;
        const float* rt = (const float*)(lds + LDS_RT) + ((ui & 1) * 256 + wr * 64 + fr) * 8 + 7;
#pragma unroll
        for (int ai = 0; ai < 2; ++ai)
#pragma unroll
            for (int m = 0; m < 4; ++m) { bf16_t* rowp = O + (size_t)(row0 + ai * 128 + m * 16) * ldc + col0; const float f = rt[(ai * 128 + m * 16) * 8];
#pragma unroll
                for (int bj = 0; bj < 2; ++bj) { const f32x4 v0 = acc[ai][bj][m][0] * f, v1 = acc[ai][bj][m][1] * f;
                    u32x4 o; o.x = pk2(v0[0], v0[1]); o.y = pk2(v0[2], v0[3]); o.z = pk2(v1[0], v1[1]); o.w = pk2(v1[2], v1[3]);
                    *(u32x4*)(rowp + bj * 128) = o; } }
    }
};
struct EpiBCV {
    static constexpr bool GROUPS = false;
    bf16_t* O;
    __device__ __forceinline__ void operator()(const f32x4 (&acc)[2][2][4][2], const pg8::Unit& u, int wr, int wc, int fr, int fq, int) const {
        const int row0 = u.pm * 256 + wr * 64 + fr;
        if (u.pn < 4) {
            const int col0 = u.pn * 256 + wc * 32 + 8 * fq;
#pragma unroll
            for (int ai = 0; ai < 2; ++ai)
#pragma unroll
                for (int m = 0; m < 4; ++m) { bf16_t* rowp = O + (size_t)(row0 + ai * 128 + m * 16) * 2048 + col0;
#pragma unroll
                    for (int bj = 0; bj < 2; ++bj) { const f32x4 v0 = acc[ai][bj][m][0], v1 = acc[ai][bj][m][1];
                        u32x4 o; o.x = pk2(v0[0], v0[1]); o.y = pk2(v0[2], v0[3]); o.z = pk2(v1[0], v1[1]); o.w = pk2(v1[2], v1[3]);
                        *(u32x4*)(rowp + bj * 128) = o; } }
        } else {
            const int col0 = 1024 + (u.pn - 4) * 128 + wc * 32 + 8 * fq;
#pragma unroll
            for (int ai = 0; ai < 2; ++ai)
#pragma unroll
                for (int m = 0; m < 4; ++m) { bf16_t* rowp = O + (size_t)(row0 + ai * 128 + m * 16) * 2048 + col0;
                    const f32x4 v0 = acc[ai][0][m][0] * acc[ai][1][m][0], v1 = acc[ai][0][m][1] * acc[ai][1][m][1];
                    u32x4 o; o.x = pk2(v0[0], v0[1]); o.y = pk2(v0[2], v0[3]); o.z = pk2(v1[0], v1[1]); o.w = pk2(v1[2], v1[3]);
                    *(u32x4*)rowp = o; }
        }
    }
};
struct EpiSwiGLU {
    static constexpr bool GROUPS = false;
    bf16_t* O;
    __device__ __forceinline__ void operator()(const f32x4 (&acc)[2][2][4][2], const pg8::Unit& u, int wr, int wc, int fr, int fq, int) const {
        const int row0 = u.pm * 256 + wr * 64 + fr, col0 = u.pn * 128 + wc * 32 + 8 * fq;
#pragma unroll
        for (int ai = 0; ai < 2; ++ai)
#pragma unroll
            for (int m = 0; m < 4; ++m) { bf16_t* rowp = O + (size_t)(row0 + ai * 128 + m * 16) * DFF + col0;
                float r[8];
#pragma unroll
                for (int n = 0; n < 2; ++n)
#pragma unroll
                    for (int i = 0; i < 4; ++i) { const float gt = acc[ai][0][m][n][i], up = acc[ai][1][m][n][i]; r[n * 4 + i] = silu_f(gt) * up; }
                *(u32x4*)rowp = pack8(r); }
    }
};
struct EpiSSDIn {
    static constexpr bool GROUPS = false;
    bf16_t* ZX; float* DT;
    __device__ __forceinline__ void operator()(const f32x4 (&acc)[2][2][4][2], const pg8::Unit& u, int wr, int wc, int fr, int fq, int) const {
        const int row0 = u.pm * 256 + wr * 64 + fr;
        if (u.pn < 24) {
            const int col0 = u.pn * 256 + wc * 32 + 8 * fq;
#pragma unroll
            for (int ai = 0; ai < 2; ++ai)
#pragma unroll
                for (int m = 0; m < 4; ++m) { bf16_t* rowp = ZX + (size_t)(row0 + ai * 128 + m * 16) * LDZ + col0;
#pragma unroll
                    for (int bj = 0; bj < 2; ++bj) { const f32x4 v0 = acc[ai][bj][m][0], v1 = acc[ai][bj][m][1];
                        u32x4 o; o.x = pk2(v0[0], v0[1]); o.y = pk2(v0[2], v0[3]); o.z = pk2(v1[0], v1[1]); o.w = pk2(v1[2], v1[3]);
                        *(u32x4*)(rowp + bj * 128) = o; } }
        } else if (wc == 0) {
#pragma unroll
            for (int ai = 0; ai < 2; ++ai)
#pragma unroll
                for (int m = 0; m < 4; ++m) { float* rowp = DT + (size_t)(row0 + ai * 128 + m * 16) * 32 + 8 * fq;
                    *(f32x4*)(rowp) = acc[ai][0][m][0]; *(f32x4*)(rowp + 4) = acc[ai][0][m][1]; }
        }
    }
};
template <class Epi> __device__ __forceinline__ void run_gemm(uchar* sm, const bf16_t* A, int lda, const bf16_t* Bt, int ldb, int Mr, int N, int K, const Epi& E, const float* ssq = nullptr) {
    pg8::StaticOrder S; S.init(Mr, N, (int)gridDim.x, opaque_bid());
    pg8::gemm_phase<Epi>((LAS uchar*)sm, pg8::Gemm{A, Bt, Mr, N, K, lda, ldb, ssq}, S, E);
}

struct CvtJob { const float* W; bf16_t* Wt; const float* kscale; int K, N, ldw, mode, tile; };
__device__ __forceinline__ void cvt_load(const CvtJob& jb, int tid, f32x4 (&v)[2]) {
    const int nkt = jb.K / 64, nb = jb.tile / nkt, kb = jb.tile % nkt, n0 = nb * 64, k0 = kb * 64;
    const int n4 = (tid & 15) * 4, kk0 = tid >> 4; const int np = n0 + n4;
    int col = np; if (jb.mode == 1) col = ((np >> 7) & 1) * DFF + (np >> 8) * 128 + (np & 127);
    if (jb.mode == 3 && np >= 1024) { const int q = np - 1024; col = 1024 + ((q >> 7) & 1) * 1024 + (q >> 8) * 128 + (q & 127); }
    const bool valid = col < jb.N;
#pragma unroll
    for (int i = 0; i < 2; ++i) { const int kk = kk0 + 32 * i;
        v[i] = valid ? *(const f32x4*)(jb.W + (size_t)(k0 + kk) * jb.N + col) : (f32x4){0.f, 0.f, 0.f, 0.f};
        if (jb.kscale) v[i] *= jb.kscale[k0 + kk]; }
}
__device__ __forceinline__ void cvt_to_lds(int tid, const f32x4 (&v)[2], float* scr) {
    const int n4 = (tid & 15) * 4, kk0 = tid >> 4;
#pragma unroll
    for (int i = 0; i < 2; ++i) { float* d = scr + (kk0 + 32 * i) * 65 + n4; d[0] = v[i][0]; d[1] = v[i][1]; d[2] = v[i][2]; d[3] = v[i][3]; }
}
__device__ __forceinline__ void cvt_store(const CvtJob& jb, int tid, const float* scr) {
    const int nkt = jb.K / 64, nb = jb.tile / nkt, kb = jb.tile % nkt, n0 = nb * 64, k0 = kb * 64;
    const int nl = tid >> 3, kc = tid & 7; const float* sp = scr + (kc * 8) * 65 + nl;
    u32x4 o; o.x = pk2(sp[0], sp[65]); o.y = pk2(sp[2 * 65], sp[3 * 65]); o.z = pk2(sp[4 * 65], sp[5 * 65]); o.w = pk2(sp[6 * 65], sp[7 * 65]);
    *(u32x4*)(jb.Wt + (size_t)(n0 + nl) * jb.ldw + k0 + kc * 8) = o;
}
__device__ __forceinline__ void convert_layer_weights(const Params& p, uchar* sm, int i, bool mixer, bool ffn) {
    float* scr = (float*)sm;
    const int j = i >> 1, bid = opaque_bid(), tid = opaque_tid();
    const int T_AWIN = (3072 / 64) * 16, T_AWOUT = 16 * 16, T_MWIN = (MIN_NP / 64) * 16, T_MWOUT = 16 * 32, T_FWIN = (5632 / 64) * 16, T_FWOUT = 16 * 44;
    const bool conv = (i & 1) == 0;
    const int t_in = conv ? T_AWIN : T_MWIN, t_out = conv ? T_AWOUT : T_MWOUT;
    const int n_mix = mixer ? t_in + t_out : 0, n_ffn = ffn ? T_FWIN + T_FWOUT : 0, n_all = n_mix + n_ffn;
    auto job = [&](int it) -> CvtJob {
        int r = it;
        if (r < n_mix) {
            if (conv) {
                if (r < t_in) return CvtJob{p.a_w_in + (size_t)j * 1024 * 3072, (bf16_t*)(p.ws + WS_WMIX), nullptr, 1024, 3072, LDW1, 3, r};
                return CvtJob{p.a_w_out + (size_t)j * 1024 * 1024, (bf16_t*)(p.ws + WS_WMIX + OFF_W2), nullptr, 1024, 1024, LDW1, 0, r - t_in};
            }
            if (r < t_in) return CvtJob{p.m_w_in + (size_t)j * 1024 * MIN_N, (bf16_t*)(p.ws + WS_WMIX), nullptr, 1024, MIN_N, LDW1, 0, r};
            return CvtJob{p.m_w_out + (size_t)j * 2048 * 1024, (bf16_t*)(p.ws + WS_WMIX + OFF_W2), p.m_norm_g + (size_t)j * DI, 2048, 1024, LDW2, 0, r - t_in};
        }
        r -= n_mix;
        if (r < T_FWIN) return CvtJob{p.f_w_in + (size_t)i * 1024 * 5632, (bf16_t*)(p.ws + WS_WFFN), nullptr, 1024, 5632, LDW1, 1, r};
        return CvtJob{p.f_w_out + (size_t)i * 2816 * 1024, (bf16_t*)(p.ws + WS_WFFN + OFF_F2), nullptr, 2816, 1024, 2816, 0, r - T_FWIN};
    };
    f32x4 cur[2], nxt[2];
    int it = bid;
    if (it < n_all) cvt_load(job(it), tid, cur);
    for (; it < n_all; it += gridDim.x) {
        const CvtJob jb = job(it);
        cvt_to_lds(tid, cur, scr);
        if (it + (int)gridDim.x < n_all) cvt_load(job(it + gridDim.x), tid, nxt);
        __syncthreads();
        cvt_store(jb, tid, scr);
        __syncthreads();
        cur[0] = nxt[0]; cur[1] = nxt[1];
    }
}
__device__ __forceinline__ void phase_prologue(const Params& p, uchar* sm) {
    const int tid = opaque_tid(), w = tid >> 6, lane = tid & 63; const int bid = opaque_bid();
    float* mod = (float*)(p.ws + WS_MOD);
    float* sc = (float*)sm;
    float* red = sc + 16 * 1024;
    for (int i = tid; i < 16 * 1024; i += 512) sc[i] = silu_f(p.c[i]);
    __syncthreads();
    for (int item = bid; item < NMODV / 64; item += gridDim.x) {
        const int col = item * 64 + lane;
        float acc[16];
#pragma unroll
        for (int b = 0; b < 16; ++b) acc[b] = 0.f;
        const float* wp = p.ada_w + (size_t)(w * 128) * NMODV + col;
#pragma unroll 4
        for (int k = 0; k < 128; ++k) { const float wv = wp[(size_t)k * NMODV];
#pragma unroll
            for (int b = 0; b < 16; ++b) acc[b] += sc[b * 1024 + w * 128 + k] * wv; }
#pragma unroll
        for (int b = 0; b < 16; ++b) red[(w * 16 + b) * 64 + lane] = acc[b];
        __syncthreads();
        for (int o = tid; o < 1024; o += 512) { const int b = o >> 6, cl = o & 63; float s = p.ada_b[item * 64 + cl];
#pragma unroll
            for (int q = 0; q < 8; ++q) s += red[(q * 16 + b) * 64 + cl];
            mod[(size_t)b * NMODV + item * 64 + cl] = s; }
        __syncthreads();
    }
    convert_layer_weights(p, sm, 0, true, true);
}

__device__ __forceinline__ void phase_rowwise(const Params& p, const float* xs32, const bf16_t* xs16, float* xd32, bf16_t* xd16, const bf16_t* y, const float* gpost, int modres,
                                              bf16_t* hout, const float* gpre, int modh) {
    constexpr int RB = 4;
    const int tid = opaque_tid(), lane = tid & 63;
    const int gw = opaque_bid() * 8 + (tid >> 6), nw = gridDim.x * 8;
    const float* mod = (const float*)(p.ws + WS_MOD);
    for (int rg = gw; rg < M / RB; rg += nw) {
        const size_t row0 = (size_t)rg * RB;
        const float* modb = mod + (size_t)((rg * RB) >> 11) * NMODV;
        f32x4 xv[RB][4];
        if (xs32) {
#pragma unroll
            for (int r = 0; r < RB; ++r)
#pragma unroll
                for (int j = 0; j < 4; ++j) xv[r][j] = *(const f32x4*)(xs32 + (row0 + r) * D + lane * 4 + 256 * j);
        } else {
#pragma unroll
            for (int r = 0; r < RB; ++r)
#pragma unroll
                for (int j = 0; j < 4; ++j) { const u32x2 t = *(const u32x2*)(xs16 + (row0 + r) * D + lane * 4 + 256 * j);
                    xv[r][j][0] = bflo(t.x); xv[r][j][1] = bfhi(t.x); xv[r][j][2] = bflo(t.y); xv[r][j][3] = bfhi(t.y); }
        }
        if (y) {
            u32x2 yp[RB][4];
#pragma unroll
            for (int r = 0; r < RB; ++r)
#pragma unroll
                for (int j = 0; j < 4; ++j) yp[r][j] = *(const u32x2*)(y + (row0 + r) * LDH + lane * 4 + 256 * j);
            float ss[RB];
#pragma unroll
            for (int r = 0; r < RB; ++r) { ss[r] = 0.f;
#pragma unroll
                for (int j = 0; j < 4; ++j) { const float a = bflo(yp[r][j].x), b = bfhi(yp[r][j].x), c = bflo(yp[r][j].y), d = bfhi(yp[r][j].y); ss[r] += (a * a + b * b) + (c * c + d * d); } }
#pragma unroll
            for (int o = 1; o < 64; o <<= 1)
#pragma unroll
                for (int r = 0; r < RB; ++r) ss[r] += __shfl_xor(ss[r], o);
#pragma unroll
            for (int j = 0; j < 4; ++j) { const f32x4 gt = *(const f32x4*)(modb + modres + lane * 4 + 256 * j), gp = *(const f32x4*)(gpost + lane * 4 + 256 * j);
                const f32x4 gg = gt * gp;
#pragma unroll
                for (int r = 0; r < RB; ++r) { const float rstd = rsqrtf(ss[r] * (1.f / D) + EPS);
                    xv[r][j][0] += gg[0] * (bflo(yp[r][j].x) * rstd); xv[r][j][1] += gg[1] * (bfhi(yp[r][j].x) * rstd);
                    xv[r][j][2] += gg[2] * (bflo(yp[r][j].y) * rstd); xv[r][j][3] += gg[3] * (bfhi(yp[r][j].y) * rstd);
                    if (xd32) *(f32x4*)(xd32 + (row0 + r) * D + lane * 4 + 256 * j) = xv[r][j];
                    if (xd16) { u32x2 o; o.x = pk2(xv[r][j][0], xv[r][j][1]); o.y = pk2(xv[r][j][2], xv[r][j][3]);
                        *(u32x2*)(xd16 + (row0 + r) * D + lane * 4 + 256 * j) = o;
                        xv[r][j][0] = bflo(o.x); xv[r][j][1] = bfhi(o.x); xv[r][j][2] = bflo(o.y); xv[r][j][3] = bfhi(o.y); } } }
        }
        if (hout) {
            float ss[RB];
#pragma unroll
            for (int r = 0; r < RB; ++r) { ss[r] = 0.f;
#pragma unroll
                for (int j = 0; j < 4; ++j) ss[r] += (xv[r][j][0] * xv[r][j][0] + xv[r][j][1] * xv[r][j][1]) + (xv[r][j][2] * xv[r][j][2] + xv[r][j][3] * xv[r][j][3]); }
#pragma unroll
            for (int o = 1; o < 64; o <<= 1)
#pragma unroll
                for (int r = 0; r < RB; ++r) ss[r] += __shfl_xor(ss[r], o);
#pragma unroll
            for (int j = 0; j < 4; ++j) { const f32x4 sh = *(const f32x4*)(modb + modh + lane * 4 + 256 * j), scl = *(const f32x4*)(modb + modh + 1024 + lane * 4 + 256 * j), gp = *(const f32x4*)(gpre + lane * 4 + 256 * j);
                const f32x4 gs = gp * (scl + 1.f);
#pragma unroll
                for (int r = 0; r < RB; ++r) { const float rstd = rsqrtf(ss[r] * (1.f / D) + EPS);
                    u32x2 o; o.x = pk2(xv[r][j][0] * rstd * gs[0] + sh[0], xv[r][j][1] * rstd * gs[1] + sh[1]); o.y = pk2(xv[r][j][2] * rstd * gs[2] + sh[2], xv[r][j][3] * rstd * gs[3] + sh[3]);
                    *(u32x2*)(hout + (row0 + r) * LDH + lane * 4 + 256 * j) = o; } }
        }
    }
}

__device__ __forceinline__ void phase_convA(const Params& p, const bf16_t* bcv  , bf16_t* tout, const float* cw  ) {
    const int nthr = gridDim.x * 512;
    for (int id = opaque_bid() * 512 + opaque_tid(); id < 128 * 2048; id += nthr) {
        const int c8 = id & 127, rg = id >> 7;
        float w0[8], w1[8], w2[8];
#pragma unroll
        for (int h = 0; h < 2; ++h) { const f32x4 a = *(const f32x4*)(cw + c8 * 8 + h * 4), b = *(const f32x4*)(cw + 1024 + c8 * 8 + h * 4), c = *(const f32x4*)(cw + 2048 + c8 * 8 + h * 4);
#pragma unroll
            for (int i = 0; i < 4; ++i) { w0[h * 4 + i] = a[i]; w1[h * 4 + i] = b[i]; w2[h * 4 + i] = c[i]; } }
        const size_t r0 = (size_t)rg * 16;
        float cvm2[8], cvm1[8];
#pragma unroll
        for (int i = 0; i < 8; ++i) { cvm2[i] = 0.f; cvm1[i] = 0.f; }
        if ((r0 & 2047) != 0) {
            unpack8(*(const u32x4*)(bcv + (r0 - 2) * 2048 + 1024 + c8 * 8), cvm2);
            unpack8(*(const u32x4*)(bcv + (r0 - 1) * 2048 + 1024 + c8 * 8), cvm1);
        }
        u32x4 bq[4], cq[4];
#pragma unroll
        for (int q = 0; q < 4; ++q) { const bf16_t* rp = bcv + (r0 + q) * 2048 + c8 * 8; bq[q] = *(const u32x4*)rp; cq[q] = *(const u32x4*)(rp + 1024); }
#pragma unroll
        for (int bt = 0; bt < 4; ++bt) {
            u32x4 bn[4], cn[4];
            if (bt < 3) {
#pragma unroll
                for (int q = 0; q < 4; ++q) { const bf16_t* rp = bcv + (r0 + (bt + 1) * 4 + q) * 2048 + c8 * 8; bn[q] = *(const u32x4*)rp; cn[q] = *(const u32x4*)(rp + 1024); }
            }
#pragma unroll
            for (int q = 0; q < 4; ++q) {
                float bb[8], cv[8], o[8];
                unpack8(bq[q], bb); unpack8(cq[q], cv);
#pragma unroll
                for (int i = 0; i < 8; ++i) { o[i] = bb[i] * (w0[i] * cvm2[i] + w1[i] * cvm1[i] + w2[i] * cv[i]); cvm2[i] = cvm1[i]; cvm1[i] = cv[i]; }
                *(u32x4*)(tout + (r0 + bt * 4 + q) * LDH + c8 * 8) = pack8(o);
            }
            if (bt < 3) {
#pragma unroll
                for (int q = 0; q < 4; ++q) { bq[q] = bn[q]; cq[q] = cn[q]; }
            }
        }
    }
}

constexpr int L_C = 0, L_B = 17408, L_BT = 34816, L_XT = 53248, L_ST = 71680, L_CB = 106496, L_DT = 123904, L_CS = 124416, L_E1 = 124928, L_E2 = 125440;
constexpr int RS_CB = 272, RS_T = 144, RS_Y = 528;

__device__ __forceinline__ void load_raw(const bf16_t* base, int toff, bool first, int lrow, u32x4 (&raw)[5]) {
#pragma unroll
    for (int q = 0; q < 5; ++q) {
        if (!first || lrow - 3 + q >= 0) raw[q] = *(const u32x4*)(base + (q - 3) * LDZ + toff);
        else raw[q] = (u32x4){0u, 0u, 0u, 0u}; }
}
__device__ __forceinline__ void conv_rows(const u32x4 (&rawp)[5], const float* wl, float (&o0)[8], float (&o1)[8]) {
    float raw[5][8];
#pragma unroll
    for (int q = 0; q < 5; ++q) unpack8(rawp[q], raw[q]);
#pragma unroll
    for (int h = 0; h < 2; ++h) {
        const f32x4 bv = *(const f32x4*)(wl + 4 * 128 + h * 4);
        f32x4 a0 = bv, a1 = bv;
#pragma unroll
        for (int k = 0; k < 4; ++k) { const f32x4 wv = *(const f32x4*)(wl + k * 128 + h * 4);
#pragma unroll
            for (int i = 0; i < 4; ++i) { a0[i] += wv[i] * raw[k][h * 4 + i]; a1[i] += wv[i] * raw[k + 1][h * 4 + i]; } }
#pragma unroll
        for (int i = 0; i < 4; ++i) { o0[h * 4 + i] = silu_f(a0[i]); o1[h * 4 + i] = silu_f(a1[i]); }
        __builtin_amdgcn_sched_barrier(0);
    }
}

__device__ __forceinline__ void phase_ssd(const Params& p, uchar* sm, int j, bf16_t* zx, const float* dtraw, float* ssqb) {
    const int tid = opaque_tid(), w = tid >> 6, lane = tid & 63, l15 = lane & 15, quad = lane >> 4;
    const float* convw = p.m_conv_w + (size_t)j * 4 * CONVD; const float* convb = p.m_conv_b + (size_t)j * CONVD;
    const int c8 = tid & 15, lp = tid >> 4;
    const int chl = w * 16, rl = w >> 2;
    float* dtL = (float*)(sm + L_DT); float* csL = (float*)(sm + L_CS); float* e1L = (float*)(sm + L_E1); float* e2L = (float*)(sm + L_E2);
    for (int item = opaque_bid(); item < 256; item += gridDim.x) {
        const int bl = item >> 4, g = (item >> 1) & 7, hp = item & 1;
        const int headA = g * 4 + hp * 2;
        const int xch = g * 256 + hp * 128 + c8 * 8;
        float a_coef = 0.f, dtb = 0.f;
        const bool tabw = (w == 1 || w == 3); const int th = w >> 1;
        if (tabw) { a_coef = -__expf(p.m_a_log[j * 32 + headA + th]); dtb = p.m_dt_bias[j * 32 + headA + th]; }
        const float dskip = p.m_d[j * 32 + headA + (c8 >> 3)];
        f32x4 st[8];
#pragma unroll
        for (int n = 0; n < 8; ++n) st[n] = (f32x4){0.f, 0.f, 0.f, 0.f};
        const int bch = 2048 + g * 128 + c8 * 8, cch = 3072 + g * 128 + c8 * 8;
        const int swz = 4 * (c8 >> 1);
        u32x4 rx[5], rb[5], rc[5];
        {
            float* wl = (float*)(sm + LDS_WL);
            if (tid < 480) { const int t = tid / 160, k = (tid % 160) >> 5, c4 = tid & 31;
                const int ch = (t == 0 ? g * 256 + hp * 128 : (t == 1 ? 2048 + g * 128 : 3072 + g * 128)) + c4 * 4;
                *(f32x4*)(wl + (t * 5 + k) * 128 + c4 * 4) = *(const f32x4*)((k < 4 ? convw + (size_t)k * CONVD : convb) + ch); }
            __syncthreads();
        }
        const float* wlx = (const float*)(sm + LDS_WL) + c8 * 8; const float* wlb = wlx + 5 * 128; const float* wlc = wlx + 10 * 128;
        const int toff = (2 * lp) * LDZ + c8 * 8;
        const int colx = g * 256 + hp * 128, colb = 2048 + g * 128, colc = 3072 + g * 128;
        { const bf16_t* zb = zx + (size_t)bl * SEQ * LDZ;
          load_raw(zb + 2048 + colx, toff, true, 2 * lp, rx); load_raw(zb + 2048 + colb, toff, true, 2 * lp, rb); load_raw(zb + 2048 + colc, toff, true, 2 * lp, rc);
        }
        float dtr = 0.f;
        if (tabw) dtr = dtraw[((long)bl * SEQ + lane) * 32 + headA + th];
        for (int c = 0; c < 32; ++c) {
            const long zrow0 = (long)bl * SEQ + c * 64;
            float xo0[8], xo1[8];
            conv_rows(rx, wlx, xo0, xo1);
            __builtin_amdgcn_sched_barrier(0);
#pragma unroll
            for (int i = 0; i < 8; ++i) *(unsigned*)(sm + L_XT + (c8 * 8 + i) * RS_T + ((lp ^ swz) * 4)) = pk2(xo0[i], xo1[i]);
            {
                float t0[8], t1[8];
                __builtin_amdgcn_sched_barrier(0);
                conv_rows(rb, wlb, t0, t1);
                __builtin_amdgcn_sched_barrier(0);
                *(u32x4*)(sm + L_B + (2 * lp) * RS_CB + c8 * 16) = pack8(t0);
                *(u32x4*)(sm + L_B + (2 * lp + 1) * RS_CB + c8 * 16) = pack8(t1);
#pragma unroll
                for (int i = 0; i < 8; ++i) *(unsigned*)(sm + L_BT + (c8 * 8 + i) * RS_T + ((lp ^ swz) * 4)) = pk2(t0[i], t1[i]);
                __builtin_amdgcn_sched_barrier(0);
                conv_rows(rc, wlc, t0, t1);
                __builtin_amdgcn_sched_barrier(0);
                *(u32x4*)(sm + L_C + (2 * lp) * RS_CB + c8 * 16) = pack8(t0);
                *(u32x4*)(sm + L_C + (2 * lp + 1) * RS_CB + c8 * 16) = pack8(t1);
            }
            const u32x4 xp0 = pack8(xo0), xp1 = pack8(xo1);
            bf16_t* zc = zx + (size_t)zrow0 * LDZ;
            if (c + 1 < 32) { const bf16_t* zb = zc + 64 * LDZ;
                load_raw(zb + 2048 + colx, toff, false, 2 * lp, rx); }
            const u32x4 z0 = *(const u32x4*)(zc + colx + toff), z1 = *(const u32x4*)(zc + colx + LDZ + toff);
            __syncthreads();
            if (tabw) {
                const float v = dtr + dtb;
                const float dt = v > 20.f ? v : log1pf(__expf(v));
                const float cs = wave_incl_scan(dt * a_coef);
                const float c63 = __int_as_float(__builtin_amdgcn_readlane(__float_as_int(cs), 63));
                dtL[th * 64 + lane] = dt; csL[th * 64 + lane] = cs; e1L[th * 64 + lane] = __expf(cs); e2L[th * 64 + lane] = dt * __expf(c63 - cs);
                if (c + 1 < 32) dtr = dtraw[(zrow0 + 64 + lane) * 32 + headA + th];
            } else {
                const int lt = w >> 1, st0 = (w & 1) * 2;
                f32x4 cacc[2] = {(f32x4){0.f, 0.f, 0.f, 0.f}, (f32x4){0.f, 0.f, 0.f, 0.f}};
#pragma unroll
                for (int ks = 0; ks < 4; ++ks) {
                    const bf16x8 a = *(const bf16x8*)(sm + L_C + (lt * 16 + l15) * RS_CB + (ks * 32 + quad * 8) * 2);
#pragma unroll
                    for (int q = 0; q < 2; ++q) { const bf16x8 b = *(const bf16x8*)(sm + L_B + ((st0 + q) * 16 + l15) * RS_CB + (ks * 32 + quad * 8) * 2);
                        cacc[q] = __builtin_amdgcn_mfma_f32_16x16x32_bf16(a, b, cacc[q], 0, 0, 0); }
                }
#pragma unroll
                for (int q = 0; q < 2; ++q)
#pragma unroll
                    for (int r = 0; r < 4; ++r) *(float*)(sm + L_CB + (lt * 16 + quad * 4 + r) * RS_CB + ((st0 + q) * 16 + l15) * 4) = cacc[q][r];
            }
            __syncthreads();
            {
                const int mq = w & 3; const int l = mq * 16 + l15; const float csl = csL[rl * 64 + l];
#pragma unroll
                for (int ks = 0; ks < 2; ++ks) {
                    if (ks == 1 && mq < 2) continue;
                    const f32x4 s0 = *(const f32x4*)(csL + rl * 64 + ks * 32 + quad * 8), s1 = *(const f32x4*)(csL + rl * 64 + ks * 32 + quad * 8 + 4);
                    const f32x4 c0 = *(const f32x4*)(sm + L_CB + l * RS_CB + (ks * 32 + quad * 8) * 4), c1 = *(const f32x4*)(sm + L_CB + l * RS_CB + (ks * 32 + quad * 8 + 4) * 4);
                    float mv[8];
#pragma unroll
                    for (int i = 0; i < 4; ++i) { const int sc = ks * 32 + quad * 8 + i;
                        mv[i] = (sc <= l) ? c0[i] * __expf(csl - s0[i]) : 0.f;
                        mv[4 + i] = (sc + 4 <= l) ? c1[i] * __expf(csl - s1[i]) : 0.f; }
                    *(u32x4*)(sm + LDS_MM + (rl * 64 + l) * RS_T + (ks * 32 + quad * 8) * 2) = pack8(mv);
                }
            }
            f32x4 yacc[4];
            {
                uchar* stw = sm + L_ST + w * (16 * RS_CB);
#pragma unroll
                for (int n = 0; n < 8; ++n) { u32x2 o; o.x = pk2(st[n][0], st[n][1]); o.y = pk2(st[n][2], st[n][3]);
                    *(u32x2*)(stw + l15 * RS_CB + (n * 16 + quad * 4) * 2) = o; }
#pragma unroll
                for (int m = 0; m < 4; ++m) yacc[m] = (f32x4){0.f, 0.f, 0.f, 0.f};
#pragma unroll
                for (int ks = 0; ks < 4; ++ks) {
                    const bf16x8 bfr = *(const bf16x8*)(stw + l15 * RS_CB + (ks * 32 + quad * 8) * 2);
#pragma unroll
                    for (int m = 0; m < 4; ++m) { const bf16x8 afr = *(const bf16x8*)(sm + L_C + (m * 16 + l15) * RS_CB + (ks * 32 + quad * 8) * 2);
                        yacc[m] = __builtin_amdgcn_mfma_f32_16x16x32_bf16(afr, bfr, yacc[m], 0, 0, 0); }
                }
#pragma unroll
                for (int m = 0; m < 4; ++m) { const f32x4 ev = *(const f32x4*)(e1L + rl * 64 + m * 16 + quad * 4);
#pragma unroll
                    for (int r = 0; r < 4; ++r) yacc[m][r] *= ev[r]; }
                const float cs63 = csL[rl * 64 + 63];
                bf16x8 xdt[2], xdd[2];
#pragma unroll
                for (int ks = 0; ks < 2; ++ks) {
                    float xr[8]; unpack8(*(const u32x4*)(sm + L_XT + (chl + l15) * RS_T + (((ks * 16 + quad * 4) ^ (4 * w)) * 4)), xr);
                    const f32x4 d0 = *(const f32x4*)(dtL + rl * 64 + ks * 32 + quad * 8), d1 = *(const f32x4*)(dtL + rl * 64 + ks * 32 + quad * 8 + 4);
                    const f32x4 g0 = *(const f32x4*)(e2L + rl * 64 + ks * 32 + quad * 8), g1 = *(const f32x4*)(e2L + rl * 64 + ks * 32 + quad * 8 + 4);
                    float a[8], b[8];
#pragma unroll
                    for (int i = 0; i < 4; ++i) { a[i] = xr[i] * d0[i]; a[4 + i] = xr[4 + i] * d1[i]; b[i] = xr[i] * g0[i]; b[4 + i] = xr[4 + i] * g1[i]; }
                    const u32x4 pa = pack8(a), pb = pack8(b);
                    xdt[ks] = __builtin_bit_cast(bf16x8, pa); xdd[ks] = __builtin_bit_cast(bf16x8, pb);
                }
                __syncthreads();
#pragma unroll
                for (int ks = 0; ks < 2; ++ks)
#pragma unroll
                    for (int m = 0; m < 4; ++m) {
                        if (ks == 1 && m < 2) continue;
                        const bf16x8 afr = *(const bf16x8*)(sm + LDS_MM + (rl * 64 + m * 16 + l15) * RS_T + (ks * 32 + quad * 8) * 2);
                        yacc[m] = __builtin_amdgcn_mfma_f32_16x16x32_bf16(afr, xdt[ks], yacc[m], 0, 0, 0);
                    }
                const float dec = e1L[rl * 64 + 63];
#pragma unroll
                for (int n = 0; n < 8; ++n) {
                    st[n] *= dec;
#pragma unroll
                    for (int ks = 0; ks < 2; ++ks) { const bf16x8 afr = *(const bf16x8*)(sm + L_BT + (n * 16 + l15) * RS_T + (((ks * 16 + quad * 4) ^ (4 * n)) * 4));
                        st[n] = __builtin_amdgcn_mfma_f32_16x16x32_bf16(afr, xdd[ks], st[n], 0, 0, 0); }
                }
            }
            if (c + 1 < 32) { load_raw(zc + 64 * LDZ + 2048 + colb, toff, false, 2 * lp, rb); load_raw(zc + 64 * LDZ + 2048 + colc, toff, false, 2 * lp, rc); }
            __syncthreads();
#pragma unroll
            for (int m = 0; m < 4; ++m)
#pragma unroll
                for (int r = 0; r < 4; ++r) *(float*)(sm + (m * 16 + quad * 4 + r) * RS_Y + (chl + l15) * 4) = yacc[m][r];
            __syncthreads();
            {
                float zf[8], o[8], xf[8];
                const f32x4 y0 = *(const f32x4*)(sm + (2 * lp) * RS_Y + c8 * 32), y1 = *(const f32x4*)(sm + (2 * lp) * RS_Y + c8 * 32 + 16);
                unpack8(z0, zf); unpack8(xp0, xf);
#pragma unroll
                for (int i = 0; i < 4; ++i) { o[i] = (y0[i] + dskip * xf[i]) * silu_f(zf[i]); o[4 + i] = (y1[i] + dskip * xf[4 + i]) * silu_f(zf[4 + i]); }
                *(u32x4*)(zc + colx + toff) = pack8(o);
                float q0 = 0.f;
#pragma unroll
                for (int i = 0; i < 8; ++i) q0 += o[i] * o[i];
                const f32x4 y2 = *(const f32x4*)(sm + (2 * lp + 1) * RS_Y + c8 * 32), y3 = *(const f32x4*)(sm + (2 * lp + 1) * RS_Y + c8 * 32 + 16);
                unpack8(z1, zf); unpack8(xp1, xf);
#pragma unroll
                for (int i = 0; i < 4; ++i) { o[i] = (y2[i] + dskip * xf[i]) * silu_f(zf[i]); o[4 + i] = (y3[i] + dskip * xf[4 + i]) * silu_f(zf[4 + i]); }
                *(u32x4*)(zc + colx + LDZ + toff) = pack8(o);
                float q1 = 0.f;
#pragma unroll
                for (int i = 0; i < 8; ++i) q1 += o[i] * o[i];
#pragma unroll
                for (int sft = 1; sft < 16; sft <<= 1) { q0 += __shfl_xor(q0, sft); q1 += __shfl_xor(q1, sft); }
                if (c8 == 0) { float* sq = ssqb + (size_t)(zrow0 + 2 * lp) * 16 + g * 2 + hp; sq[0] = q0; sq[16] = q1; }
            }
            __syncthreads();
        }
    }
}

__device__ __forceinline__ void phase_gnorm(bf16_t* yg, int ld, const float* ng) {
    const int tid = opaque_tid(), lane = tid & 63;
    const int gw = opaque_bid() * 8 + (tid >> 6), nw = gridDim.x * 8;
    for (int row = gw; row < M; row += nw) {
        bf16_t* rp = yg + (size_t)row * ld;
#pragma unroll
        for (int q = 0; q < 4; ++q) {
            const int ch = (lane + 64 * q) * 8;
            float v[8]; unpack8(*(const u32x4*)(rp + ch), v);
            float ss = 0.f;
#pragma unroll
            for (int i = 0; i < 8; ++i) ss += v[i] * v[i];
#pragma unroll
            for (int o = 1; o < 32; o <<= 1) ss += __shfl_xor(ss, o);
            const float rstd = rsqrtf(ss * (1.f / 256.f) + EPS);
            const f32x4 g0 = *(const f32x4*)(ng + ch), g1 = *(const f32x4*)(ng + ch + 4);
#pragma unroll
            for (int i = 0; i < 4; ++i) { v[i] = v[i] * rstd * g0[i]; v[4 + i] = v[4 + i] * rstd * g1[i]; }
            *(u32x4*)(rp + ch) = pack8(v);
        }
    }
}

__global__ void __launch_bounds__(512, 2) fwd_megakernel(Params p) {
    extern __shared__ __attribute__((aligned(16))) uchar smem[];
    cg::grid_group grid = cg::this_grid();
    int ph = 0;
    unsigned* barw = (unsigned*)(p.ws + WS_BAR);
    volatile LAS unsigned* bst = (volatile LAS unsigned*)(LAS uchar*)(smem + LDS_MAIN);
    if (threadIdx.x == 0) { bst[0] = 0u; bst[1] = 0u; }
    if (p.ph_hi - p.ph_lo > 1 && blockIdx.x == 0) for (int i = threadIdx.x; i < XCD_BAR_WORDS; i += 512) barw[i] = 0u;
    __syncthreads();
    XcdBarrier xb; xb.bar = barw; xb.x = 0u; xb.st = bst;
    bool posted = false;
#define GSYNC() do { if (!posted) { grid.sync(); xb = xcd_barrier_post(barw, bst); posted = true; } else xcd_barrier(xb); } while (0)
#ifndef DUP_GEMM
#define DUP_GEMM 1
#endif
#ifndef DUP_SSD
#define DUP_SSD 1
#endif
#ifndef DUP_SYNC
#define DUP_SYNC 1
#endif
#ifndef DUP_MISC
#define DUP_MISC 1
#endif
#define PHASE_N(n, body) do { if (ph >= p.ph_lo && ph < p.ph_hi) { for (int _r = 0; _r < (n); ++_r) { if (ph > p.ph_lo || _r) { for (int _s = 0; _s < DUP_SYNC; ++_s) GSYNC(); } body; } } ++ph; } while (0)
#define PHASE(body) PHASE_N(1, body)
    bf16_t* hy = (bf16_t*)p.out;
    bf16_t* xres = (bf16_t*)(p.ws + WS_XB); bf16_t* ylast = (bf16_t*)(p.ws + WS_YL);
    const bf16_t* wmix = (const bf16_t*)(p.ws + WS_WMIX); const bf16_t* wffn = (const bf16_t*)(p.ws + WS_WFFN);
    PHASE_N(DUP_MISC, phase_prologue(p, smem));
#pragma unroll 1
    for (int jp = 0; jp < 2; ++jp) {
#pragma unroll 1
        for (int kind = 0; kind < 2; ++kind) {
            const int i = 2 * jp + kind;
            const float* ng = p.norm_g + (size_t)i * 4 * D;
            const int modi = i * 6 * D;
            if (i == 0) PHASE(phase_rowwise(p, p.x, nullptr, nullptr, nullptr, nullptr, nullptr, 0, hy, ng, modi));
            else PHASE({ phase_rowwise(p, nullptr, xres, nullptr, xres, hy, p.norm_g + (size_t)((i - 1) * 4 + 3) * D, (i - 1) * 6 * D + 5 * D, hy, ng, modi); convert_layer_weights(p, smem, i, false, true); });
            if (kind == 0) {
                bf16_t* bcv = (bf16_t*)(p.ws + WS_BCV); bf16_t* tb = (bf16_t*)(p.ws + WS_T);
                PHASE_N(DUP_GEMM, run_gemm(smem, hy, LDH, wmix, LDW1, M, 3072, 1024, EpiBCV{bcv}));
                PHASE_N(DUP_MISC, phase_convA(p, bcv, tb, p.a_conv_w + (size_t)jp * 3 * D));
                PHASE_N(DUP_GEMM, run_gemm(smem, tb, LDH, (const bf16_t*)(p.ws + WS_WMIX + OFF_W2), LDW1, M, 1024, 1024, EpiStoreBf16{hy, LDH}));
            } else {
                bf16_t* zx = (bf16_t*)(p.ws + WS_ZX); float* dtr = (float*)(p.ws + WS_DTR);
                PHASE_N(DUP_GEMM, run_gemm(smem, hy, LDH, wmix, LDW1, M, MIN_NP, 1024, EpiSSDIn{zx, dtr}));
                float* ssqb = (float*)(p.ws + WS_SSQ);
                PHASE_N(DUP_SSD, phase_ssd(p, smem, jp, zx, dtr, ssqb));
                PHASE_N(DUP_GEMM, run_gemm(smem, zx, LDZ, (const bf16_t*)(p.ws + WS_WMIX + OFF_W2), LDW2, M, 1024, 2048, EpiStoreGroupNorm{hy, LDH, smem}, ssqb));
            }
            PHASE({ phase_rowwise(p, i == 0 ? p.x : nullptr, xres, nullptr, xres, hy, ng + D, modi + 2 * D, hy, ng + 2 * D, modi + 3 * D); if (i < 3) convert_layer_weights(p, smem, i + 1, true, false); });
            bf16_t* act = (bf16_t*)(p.ws + WS_ACT);
            PHASE_N(DUP_GEMM, run_gemm(smem, hy, LDH, wffn, LDW1, M, 5632, 1024, EpiSwiGLU{act}));
            PHASE_N(DUP_GEMM, run_gemm(smem, act, DFF, (const bf16_t*)(p.ws + WS_WFFN + OFF_F2), DFF, M, 1024, DFF, EpiStoreBf16{i == 3 ? ylast : hy, LDH}));
        }
    }
    PHASE(phase_rowwise(p, nullptr, xres, p.out, nullptr, ylast, p.norm_g + (size_t)(3 * 4 + 3) * D, 3 * 6 * D + 5 * D, nullptr, nullptr, 0));
#undef PHASE
#undef PHASE_N
#undef GSYNC
}
constexpr int NPHASES = 1 + 2 * (1 + 3 + 1 + 2) + 2 * (1 + 3 + 1 + 2) + 1;

extern "C" void kernel_launch(void* const* d_in, const int* in_sizes, int n_in, void* d_out, int out_size, void* d_ws, size_t ws_size, hipStream_t stream) {
    static int grid = 0;
    if (grid == 0) {
        if (n_in != 18 || out_size != M * D || ws_size < WS_END) { fprintf(stderr, "kernel_launch: unexpected problem (n_in %d out %d ws %zu need %zu)\n", n_in, out_size, ws_size, (size_t)WS_END); grid = -1; return; }
        int dev = 0, cus = 0, per_cu = 0;
        hipGetDevice(&dev); hipDeviceGetAttribute(&cus, hipDeviceAttributeMultiprocessorCount, dev);
        if (hipFuncSetAttribute((const void*)fwd_megakernel, hipFuncAttributeMaxDynamicSharedMemorySize, LDS_BYTES) != hipSuccess) { fprintf(stderr, "kernel_launch: hipFuncSetAttribute failed\n"); grid = -1; return; }
        hipOccupancyMaxActiveBlocksPerMultiprocessor(&per_cu, (const void*)fwd_megakernel, 512, LDS_BYTES);
        (void)hipGetLastError();
        if (per_cu < 1) per_cu = 1;
        grid = cus * 1;
        fprintf(stderr, "kernel_launch: cus %d per_cu %d grid %d phases %d\n", cus, per_cu, grid, NPHASES);
    }
    if (grid < 0) return;
    Params p{};
    const float** pp = (const float**)&p;
    for (int i = 0; i < 18; ++i) pp[i] = (const float*)d_in[i];
    p.out = (float*)d_out; p.ws = (uchar*)d_ws;
#if COOP
    p.ph_lo = 0; p.ph_hi = NPHASES;
    void* args[] = {&p};
    hipError_t e = hipLaunchCooperativeKernel((const void*)fwd_megakernel, dim3(grid), dim3(512), args, LDS_BYTES, stream);
    if (e != hipSuccess) fprintf(stderr, "cooperative launch failed: %s (grid %d)\n", hipGetErrorString(e), grid);
#else
    for (int ph = 0; ph < NPHASES; ++ph) {
        p.ph_lo = ph; p.ph_hi = ph + 1;
        hipLaunchKernelGGL(fwd_megakernel, dim3(grid), dim3(512), LDS_BYTES, stream, p);
    }
#endif
}
```
